# Optimizing an MI355X kernel written in HIP

```python
import jax, jax.numpy as jnp
from jax import lax
import numpy as np

D_MODEL = 2048
BATCH = 4
SEQ = 4096
DEPTH = 2

CHUNK = 64
Q_BLOCK = 128
N_A = DEPTH // 2
N_B = DEPTH - N_A

RET_HEADS = 8
RET_QK = D_MODEL
RET_V = 2 * D_MODEL
RET_DK = RET_QK // RET_HEADS
RET_DV = RET_V // RET_HEADS

MLA_HEADS = 16
MLA_NOPE = 128
MLA_ROPE = 64
MLA_V = 128
Q_RANK = 512
KV_RANK = 512

D_FF = 5632
ROPE_THETA = 10000.0
EPS = 1e-6
N_MOD = 9
ADA_SCALE = 0.5

kernel_name = "yoco_retention_mla_macaron_adaln"


def rmsnorm(x, g):
    x32 = x.astype(jnp.float32)
    y = x32 * lax.rsqrt(jnp.mean(x32 * x32, axis=-1, keepdims=True) + EPS)
    return y.astype(x.dtype) * g


def modulate(x, g, shift, scale):
    return rmsnorm(x, g) * (1.0 + scale[:, None, :]) + shift[:, None, :]


def rope(x, pos):
    half = x.shape[-1] // 2
    inv = ROPE_THETA ** (-jnp.arange(half, dtype=jnp.float32) / half)
    ang = pos.astype(jnp.float32)[..., None] * inv
    cos = jnp.cos(ang)[:, :, None, :].astype(x.dtype)
    sin = jnp.sin(ang)[:, :, None, :].astype(x.dtype)
    x1, x2 = x[..., :half], x[..., half:]
    return jnp.concatenate([x1 * cos - x2 * sin, x1 * sin + x2 * cos], axis=-1)


def swiglu(h, w_in, w_out):
    gate, up = jnp.split(h @ w_in, 2, axis=-1)
    return (jax.nn.silu(gate) * up) @ w_out


def chunk_retention(q, k, v):
    B, S, H, dk = q.shape
    dv = v.shape[-1]
    nc = S // CHUNK
    dt = q.dtype
    log_g = jnp.log1p(-(2.0 ** (-5.0 - jnp.arange(H, dtype=jnp.float32))))
    idx = jnp.arange(CHUNK, dtype=jnp.float32)
    d_intra = jnp.exp(log_g[:, None, None] * jnp.abs(idx[:, None] - idx[None, :])).astype(dt)
    xi = jnp.exp(log_g[:, None] * (idx + 1.0)).astype(dt)
    zeta = jnp.exp(log_g[:, None] * (CHUNK - 1.0 - idx)).astype(dt)
    g_chunk = jnp.exp(log_g * CHUNK).astype(dt)

    def to_chunks(t):
        return t.reshape(B, nc, CHUNK, H, t.shape[-1]).transpose(1, 0, 3, 2, 4)

    def step(state, inp):
        qc, kc, vc = inp
        s = jnp.einsum('bhid,bhjd->bhij', qc, kc) * d_intra
        o = (jnp.einsum('bhij,bhjv->bhiv', s, vc)
             + jnp.einsum('bhid,bhdv->bhiv', qc * xi[None, :, :, None], state))
        state = (state * g_chunk[None, :, None, None]
                 + jnp.einsum('bhjd,bhjv->bhdv', kc * zeta[None, :, :, None], vc))
        return state, o

    state0 = jnp.zeros((B, H, dk, dv), dt)
    _, o = lax.scan(step, state0, (to_chunks(q), to_chunks(k), to_chunks(v)))
    return o.transpose(1, 0, 3, 2, 4).reshape(B, S, H, dv)


def retention_mixer(h, pos, w_in, gn_g, w_out):
    B, S, _ = h.shape
    q, k, v, g = jnp.split(h @ w_in, [RET_QK, 2 * RET_QK, 2 * RET_QK + RET_V], axis=-1)
    q = rope(q.reshape(B, S, RET_HEADS, RET_DK), pos) * (RET_DK ** -0.5)
    k = rope(k.reshape(B, S, RET_HEADS, RET_DK), pos)
    v = v.reshape(B, S, RET_HEADS, RET_DV)
    o = chunk_retention(q, k, v).astype(jnp.float32)
    mu = jnp.mean(o, axis=-1, keepdims=True)
    var = jnp.mean(jnp.square(o - mu), axis=-1, keepdims=True)
    on = ((o - mu) * lax.rsqrt(var + EPS)).reshape(B, S, RET_V).astype(h.dtype) * gn_g
    return (jax.nn.silu(g) * on) @ w_out


def shared_kv(x, c, pos, kv_ada_w, kv_ada_b, kv_norm_g, w_dkv, kv_latent_g, w_ukv):
    B, S, _ = x.shape
    shift, scale = jnp.split(jax.nn.silu(c) @ kv_ada_w + kv_ada_b, 2, axis=-1)
    hk = modulate(x, kv_norm_g, shift, scale)
    ckv, kr = jnp.split(hk @ w_dkv, [KV_RANK], axis=-1)
    ckv = rmsnorm(ckv, kv_latent_g)
    kr = rope(kr[:, :, None, :], pos)[:, :, 0, :]
    kv = (ckv @ w_ukv).reshape(B, S, MLA_HEADS, MLA_NOPE + MLA_V)
    kn, v = jnp.split(kv, [MLA_NOPE], axis=-1)
    return kn, kr, v


def mla_mixer(h, pos, kn, kr, v, w_dq, q_latent_g, w_uq, w_out):
    B, S, _ = h.shape
    cq = rmsnorm(h @ w_dq, q_latent_g)
    q = (cq @ w_uq).reshape(B, S, MLA_HEADS, MLA_NOPE + MLA_ROPE)
    qn, qr = jnp.split(q, [MLA_NOPE], axis=-1)
    qr = rope(qr, pos)
    scale = (MLA_NOPE + MLA_ROPE) ** -0.5
    nb = S // Q_BLOCK
    qn_b = qn.reshape(B, nb, Q_BLOCK, MLA_HEADS, MLA_NOPE).transpose(1, 0, 2, 3, 4)
    qr_b = qr.reshape(B, nb, Q_BLOCK, MLA_HEADS, MLA_ROPE).transpose(1, 0, 2, 3, 4)
    k_chunk = jnp.arange(S) // CHUNK

    def one_block(args):
        qnb, qrb, bi = args
        s = (jnp.einsum('bqhd,bkhd->bhqk', qnb, kn)
             + jnp.einsum('bqhr,bkr->bhqk', qrb, kr)).astype(jnp.float32) * scale
        q_chunk = (bi * Q_BLOCK + jnp.arange(Q_BLOCK)) // CHUNK
        mask = k_chunk[None, :] <= q_chunk[:, None]
        s = jnp.where(mask[None, None], s, -1e30)
        p = jax.nn.softmax(s, axis=-1).astype(v.dtype)
        return jnp.einsum('bhqk,bkhd->bqhd', p, v)

    o = lax.map(one_block, (qn_b, qr_b, jnp.arange(nb)))
    o = o.transpose(1, 0, 2, 3, 4).reshape(B, S, MLA_HEADS * MLA_V)
    return o @ w_out


def setup_inputs(seed: int = 0) -> dict:
    key = jax.random.key(seed)
    ks = jax.random.split(key, 24)
    f32 = jnp.float32
    D = D_MODEL

    def nrm(k, shape, fan_in, mult=1.0):
        return jax.random.normal(k, shape, f32) * (mult * fan_in ** -0.5)

    def gain(k, shape):
        return 1.0 + 0.02 * jax.random.normal(k, shape, f32)

    x = jax.random.normal(ks[0], (BATCH, SEQ, D), f32)
    c = jax.random.normal(ks[1], (BATCH, D), f32)
    offset = jax.random.randint(ks[2], (BATCH, 1), 0, 1024, dtype=jnp.int32)
    positions = offset + jnp.arange(SEQ, dtype=jnp.int32)[None, :]
    return {
        "x": x,
        "c": c,
        "positions": positions,
        "ada_w": nrm(ks[3], (DEPTH, D, N_MOD * D), D, ADA_SCALE),
        "ada_b": 0.02 * jax.random.normal(ks[4], (DEPTH, N_MOD * D), f32),
        "norm_g": gain(ks[5], (DEPTH, 3, D)),
        "ffn_w_in": nrm(ks[6], (DEPTH, 2, D, 2 * D_FF), D),
        "ffn_w_out": nrm(ks[7], (DEPTH, 2, D_FF, D), D_FF),
        "ret_w_in": nrm(ks[8], (N_A, D, 2 * RET_QK + 2 * RET_V), D),
        "ret_gn_g": gain(ks[9], (N_A, RET_V)),
        "ret_w_out": nrm(ks[10], (N_A, RET_V, D), RET_V),
        "kv_ada_w": nrm(ks[11], (D, 2 * D), D, ADA_SCALE),
        "kv_ada_b": 0.02 * jax.random.normal(ks[12], (2 * D,), f32),
        "kv_norm_g": gain(ks[13], (D,)),
        "mla_w_dkv": nrm(ks[14], (D, KV_RANK + MLA_ROPE), D),
        "kv_latent_g": gain(ks[15], (KV_RANK,)),
        "mla_w_ukv": nrm(ks[16], (KV_RANK, MLA_HEADS * (MLA_NOPE + MLA_V)), KV_RANK),
        "mla_w_dq": nrm(ks[17], (N_B, D, Q_RANK), D),
        "q_latent_g": gain(ks[18], (N_B, Q_RANK)),
        "mla_w_uq": nrm(ks[19], (N_B, Q_RANK, MLA_HEADS * (MLA_NOPE + MLA_ROPE)), Q_RANK),
        "mla_w_out": nrm(ks[20], (N_B, MLA_HEADS * MLA_V, D), MLA_HEADS * MLA_V),
        "final_g": gain(ks[21], (D,)),
    }


def reference(x, c, positions, ada_w, ada_b, norm_g, ffn_w_in, ffn_w_out,
              ret_w_in, ret_gn_g, ret_w_out, kv_ada_w, kv_ada_b, kv_norm_g,
              mla_w_dkv, kv_latent_g, mla_w_ukv, mla_w_dq, q_latent_g, mla_w_uq,
              mla_w_out, final_g):
    c_act = jax.nn.silu(c)
    kn = kr = v = None
    for l in range(DEPTH):
        mods = jnp.split(c_act @ ada_w[l] + ada_b[l], N_MOD, axis=-1)
        sh1, sc1, gt1, shm, scm, gtm, sh2, sc2, gt2 = mods
        if l == N_A:
            kn, kr, v = shared_kv(x, c, positions, kv_ada_w, kv_ada_b, kv_norm_g,
                                  mla_w_dkv, kv_latent_g, mla_w_ukv)
        h = modulate(x, norm_g[l, 0], sh1, sc1)
        x = x + 0.5 * gt1[:, None, :] * swiglu(h, ffn_w_in[l, 0], ffn_w_out[l, 0])
        h = modulate(x, norm_g[l, 1], shm, scm)
        if l < N_A:
            y = retention_mixer(h, positions, ret_w_in[l], ret_gn_g[l], ret_w_out[l])
        else:
            j = l - N_A
            y = mla_mixer(h, positions, kn, kr, v, mla_w_dq[j], q_latent_g[j],
                          mla_w_uq[j], mla_w_out[j])
        x = x + gtm[:, None, :] * y
        h = modulate(x, norm_g[l, 2], sh2, sc2)
        x = x + 0.5 * gt2[:, None, :] * swiglu(h, ffn_w_in[l, 1], ffn_w_out[l, 1])
    return rmsnorm(x, final_g)
```

```cpp
#include <hip/hip_runtime.h>
#include <cstdio>
#include <cstdint>

#ifndef MK_PER_PHASE
#define MK_PER_PHASE 0
#endif

#define GAS __attribute__((address_space(1)))
#define LAS __attribute__((address_space(3)))
typedef unsigned short bf16;
typedef short bf16x8 __attribute__((ext_vector_type(8)));
typedef short s16x4 __attribute__((ext_vector_type(4)));
typedef short v4i16_t __attribute__((ext_vector_type(4)));
typedef float f32x2 __attribute__((ext_vector_type(2)));
typedef float f32x4 __attribute__((ext_vector_type(4)));
typedef float f32x16 __attribute__((ext_vector_type(16)));
typedef unsigned u32x2 __attribute__((ext_vector_type(2)));
typedef unsigned u32x4 __attribute__((ext_vector_type(4)));
typedef __bf16 bf16x2_t __attribute__((ext_vector_type(2)));

constexpr int BATCH = 4, SEQ = 4096, M = BATCH * SEQ, D = 2048, FF = 5632, NMODV = 9 * D;
constexpr int RIN = 12288;
constexpr int MH = 16, QRANK = 512, KVRANK = 512;
constexpr float EPS = 1e-6f;
constexpr int MODS_TOTAL = 8 * NMODV + 4 * 2 * D;
constexpr int MODS_KV = 8 * NMODV;
constexpr int NCOLS_MODS = 2 * NMODV + 2 * D;

constexpr size_t MiB = 1u << 20;
constexpr size_t WS_CTL = 0, CTL_ZERO_BYTES = 1 * MiB;
constexpr size_t WS_MODSP = 1 * MiB, WS_MODS = 6 * MiB;
constexpr size_t WS_COSR = 7 * MiB, WS_SINR = 15 * MiB, WS_COSM = 23 * MiB, WS_SINM = 25 * MiB;
constexpr size_t WS_RSTAT = 27 * MiB, WS_SSQKV = 35 * MiB, WS_SSQQ = 35 * MiB + 512 * 1024;
constexpr size_t WS_WFI = 36 * MiB, WS_WFO = 212 * MiB, WS_WRI = 300 * MiB, WS_WRO = 348 * MiB, WS_WDKV = 364 * MiB, WS_WUKV = 367 * MiB,
                 WS_WDQ = 371 * MiB, WS_WUQ = 373 * MiB, WS_WMO = 376 * MiB;
constexpr size_t WS_H = 384 * MiB, WS_HK = 448 * MiB;
constexpr size_t WS_RA = 512 * MiB;
constexpr size_t WS_A = WS_RA, WS_RQ = WS_RA, WS_RK = WS_RA + 64 * MiB, WS_QQ = WS_RA, WS_AO = WS_RA + 96 * MiB;
constexpr size_t WS_RB = 688 * MiB;
constexpr size_t WS_RV = WS_RB, WS_RG = WS_RB + 128 * MiB, WS_RO = WS_RB + 256 * MiB;
constexpr size_t WS_CKVG = WS_RB, WS_CQG = WS_RB + 16 * MiB, WS_KR = WS_RB + 32 * MiB, WS_KN = WS_RB + 36 * MiB, WS_VV = WS_RB + 100 * MiB;
constexpr size_t WS_END = 1072 * MiB;
constexpr size_t WFI_ELEMS = (size_t)2 * FF * D, WFO_ELEMS = (size_t)D * FF;
constexpr int CW_TMO = 0, CW_BAR = 4096;

constexpr int RING_BYTES = 143360, LDSCTL_OFF = RING_BYTES, MISC_OFF = LDSCTL_OFF + 320, LDS_BYTES = 147456;

#define LDS_WAIT() asm volatile("s_waitcnt lgkmcnt(0)" ::: "memory")
#define VM_WAIT() asm volatile("s_waitcnt vmcnt(0)" ::: "memory")
__device__ __forceinline__ unsigned f2bf(float f) { unsigned u = __builtin_bit_cast(unsigned, f); return (u + 0x7fffu + ((u >> 16) & 1u)) >> 16; }
__device__ __forceinline__ unsigned pk2(float lo, float hi) { f32x2 v = {lo, hi}; bf16x2_t b = __builtin_convertvector(v, bf16x2_t); return __builtin_bit_cast(unsigned, b); }
__device__ __forceinline__ float bf_lo(unsigned w) { return __builtin_bit_cast(float, w << 16); }
__device__ __forceinline__ float bf_hi(unsigned w) { return __builtin_bit_cast(float, w & 0xffff0000u); }
__device__ __forceinline__ float silu_f(float x) { return x * __builtin_amdgcn_rcpf(1.0f + __builtin_amdgcn_exp2f(-1.4426950408889634f * x)); }
__device__ __forceinline__ float wave_sum(float v) {
#pragma unroll
    for (int o = 1; o < 64; o <<= 1) v += __shfl_xor(v, o);
    return v;
}

namespace pg8 {
typedef unsigned short bf16_t;
constexpr int BM = 256, BK = 64, HALF = 128, HTB = HALF * BK * 2, STAGE_BYTES = 8 * HTB, NXCD = 8, WGM = 8;
__host__ __device__ __forceinline__ int lds_byte(int r, int c) { const int st = (r >> 4) * 2 + (c >> 5), rr = r & 15, cc = c & 31, ob = rr * 64 + cc * 2; return st * 1024 + (ob ^ (((ob >> 9) & 1) << 5)); }
__host__ __device__ __forceinline__ void stage_rc(int b, int& R, int& C) { const int st = b / 1024, sb = b % 1024, swz = sb ^ (((sb >> 9) & 1) << 5); R = (st >> 1) * 16 + swz / 64; C = (st & 1) * 32 + (swz % 64) / 2; }
__host__ __device__ __forceinline__ int perm32(int rho) { const int n = rho >> 4, i = rho & 15; return 8 * (i >> 2) + 4 * n + (i & 3); }
struct Unit { int pm, pn; };
struct Gemm { const bf16_t* A; const bf16_t* Bt; int M, N, K; };
struct StaticOrder {
    int nM, nN, nwg, G, c;
    __host__ __device__ void init(int M_, int N_, int G_, int c_) { nM = M_ / BM; nN = N_ / BM; nwg = nM * nN; G = G_; c = c_; }
    __host__ __device__ bool next(int i, Unit& u) const {
        const long L = (long)i * G + c; if (L >= nwg) return false;
        int wgid = (int)L; { const int q = nwg / NXCD, r = nwg % NXCD, xcd = wgid % NXCD, off = wgid / NXCD; wgid = (xcd < r ? xcd * (q + 1) : r * (q + 1) + (xcd - r) * q) + off; }
        const int nig = WGM * nN, gid = wgid / nig, fm = gid * WGM, gsz = (nM - fm) < WGM ? (nM - fm) : WGM;
        u.pm = fm + ((wgid % nig) % gsz); u.pn = (wgid % nig) / gsz; return true;
    }
    __device__ __forceinline__ void a_ready(const Unit&) const {}
    __device__ __forceinline__ void done(const Unit&) const {}
};
template <class Epi, class Sched>
__device__ __forceinline__ void gemm_phase(LAS unsigned char* lds, const Gemm g, const Sched& S, const Epi& E) {
    const int tid = threadIdx.x, wid = __builtin_amdgcn_readfirstlane(tid >> 6), lane = tid & 63, wr = wid >> 2, wc = wid & 3, fr = lane & 15, fq = lane >> 4;
    const int K = g.K, nt = K / BK;
    unsigned voffA[2], voffB[2];
#pragma unroll
    for (int i = 0; i < 2; ++i) { int R, C; stage_rc(tid * 16 + i * 8192, R, C); const int Rb = Epi::PERM ? ((R & ~31) + perm32(R & 31)) : R;
        voffA[i] = (unsigned)(R * K + C) * 2u; voffB[i] = (unsigned)(Rb * K + C) * 2u; }
    const size_t kstep = (size_t)(BK * 2);
    const size_t hstep = (size_t)HALF * K * 2;
    const size_t tstep = 2 * hstep;
    const unsigned ldsw = (unsigned)wid * 1024u;
    const int aoff = lds_byte(wr * 64 + fr, fq * 8), boff = lds_byte(wc * 32 + fr, fq * 8);
#define PG8_SA(b, h) (((b) * 2 + (h)) * HTB)
#define PG8_SB(b, h) ((4 + (b) * 2 + (h)) * HTB)
#define PG8_STAGE(bufoff, gbase, voff) do { _Pragma("unroll") for (int _i = 0; _i < 2; ++_i) \
        __builtin_amdgcn_global_load_lds((const unsigned*)((const char*)(gbase) + (voff)[_i]), (LAS unsigned*)(lds + (bufoff) + ldsw + _i * 8192), 16, 0, 0); } while (0)
#define PG8_LDA(dst, b, h) do { _Pragma("unroll") for (int m = 0; m < 4; ++m) _Pragma("unroll") for (int k = 0; k < 2; ++k) dst[m][k] = *(const LAS bf16x8*)(lds + PG8_SA(b, h) + aoff + m * 2048 + k * 1024); } while (0)
#define PG8_LDB(dst, b, h) do { _Pragma("unroll") for (int n = 0; n < 2; ++n) _Pragma("unroll") for (int k = 0; k < 2; ++k) dst[n][k] = *(const LAS bf16x8*)(lds + PG8_SB(b, h) + boff + n * 2048 + k * 1024); } while (0)
#define PG8_MMA(ai, bj, At, Bt) do { __builtin_amdgcn_s_setprio(1); _Pragma("unroll") for (int m = 0; m < 4; ++m) _Pragma("unroll") for (int n = 0; n < 2; ++n) _Pragma("unroll") for (int k = 0; k < 2; ++k) \
        acc[ai][bj][m][n] = __builtin_amdgcn_mfma_f32_16x16x32_bf16(Bt[n][k], At[m][k], acc[ai][bj][m][n], 0, 0, 0); __builtin_amdgcn_s_setprio(0); } while (0)
#define PG8_WAIT_V(n) asm volatile("s_waitcnt vmcnt(" #n ")" ::: "memory")
#define PG8_WAIT_L(n) asm volatile("s_waitcnt lgkmcnt(" #n ")" ::: "memory")
#define PG8_BAR __builtin_amdgcn_s_barrier()
#define PG8_SCHED __builtin_amdgcn_sched_barrier(0)
    Unit cur, nxt; int ui = 0;
    if (!S.next(0, cur)) return;
    f32x4 acc[2][2][4][2];
#pragma unroll
    for (int a = 0; a < 2; ++a)
#pragma unroll
        for (int b = 0; b < 2; ++b)
#pragma unroll
            for (int m = 0; m < 4; ++m)
#pragma unroll
                for (int n = 0; n < 2; ++n) acc[a][b][m][n] = (f32x4){0.f, 0.f, 0.f, 0.f};
    bf16x8 At[4][2], B0[2][2], B1[2][2];
    const char* cA = (const char*)g.A + (size_t)cur.pm * tstep; const char* cB = (const char*)g.Bt + (size_t)cur.pn * tstep;
    S.a_ready(cur);
    PG8_STAGE(PG8_SB(0, 0), cB, voffB); PG8_STAGE(PG8_SB(0, 1), cB + hstep, voffB); PG8_STAGE(PG8_SA(0, 0), cA, voffA); PG8_STAGE(PG8_SA(0, 1), cA + hstep, voffA);
    if (wr == 1) PG8_BAR;
    PG8_WAIT_V(2); PG8_BAR;
    PG8_STAGE(PG8_SB(1, 0), cB + kstep, voffB); PG8_STAGE(PG8_SA(1, 0), cA + kstep, voffA); PG8_STAGE(PG8_SB(1, 1), cB + hstep + kstep, voffB);
    PG8_WAIT_V(6); PG8_BAR;
    for (;;) {
        const bool has_next = S.next(ui + 1, nxt);
        const char* nA = has_next ? (const char*)g.A + (size_t)nxt.pm * tstep : cA; const char* nB = has_next ? (const char*)g.Bt + (size_t)nxt.pn * tstep : cB;
        for (int t = 0; t < nt; t += 2) {
            const bool last = (t == nt - 2);
            const char* a1 = cA + (size_t)(t + 1) * kstep;
            const char* a2 = last ? nA : cA + (size_t)(t + 2) * kstep; const char* b2 = last ? nB : cB + (size_t)(t + 2) * kstep;
            const char* a3 = a2 + kstep; const char* b3 = b2 + kstep;
            if (last && has_next) S.a_ready(nxt);
            PG8_LDB(B0, 0, 0); PG8_LDB(B1, 0, 1); PG8_SCHED; PG8_LDA(At, 0, 0); PG8_STAGE(PG8_SA(1, 1), a1 + hstep, voffA);
            PG8_WAIT_V(8); PG8_WAIT_L(0); PG8_BAR; PG8_MMA(0, 0, At, B0); PG8_MMA(0, 1, At, B1); PG8_BAR; PG8_SCHED;
            PG8_LDA(At, 0, 1); PG8_STAGE(PG8_SB(0, 0), b2, voffB); PG8_STAGE(PG8_SB(0, 1), b2 + hstep, voffB); PG8_STAGE(PG8_SA(0, 0), a2, voffA);
            PG8_WAIT_V(8); PG8_WAIT_L(0); PG8_BAR; PG8_MMA(1, 0, At, B0); PG8_MMA(1, 1, At, B1); PG8_BAR; PG8_SCHED;
            PG8_LDB(B0, 1, 0); PG8_LDB(B1, 1, 1); PG8_SCHED; PG8_LDA(At, 1, 0); PG8_STAGE(PG8_SA(0, 1), a2 + hstep, voffA);
            PG8_WAIT_V(8); PG8_WAIT_L(0); PG8_BAR; PG8_MMA(0, 0, At, B0); PG8_MMA(0, 1, At, B1); PG8_BAR; PG8_SCHED;
            PG8_LDA(At, 1, 1); PG8_STAGE(PG8_SB(1, 0), b3, voffB); PG8_STAGE(PG8_SB(1, 1), b3 + hstep, voffB); PG8_STAGE(PG8_SA(1, 0), a3, voffA);
            PG8_WAIT_V(8); PG8_WAIT_L(0); PG8_BAR; PG8_MMA(1, 0, At, B0); PG8_MMA(1, 1, At, B1); PG8_BAR; PG8_SCHED;
        }
        if (wr == 0) PG8_BAR;
        E(acc, cur, wr, wc, fr, fq); S.done(cur);
        if (!has_next) break;
#pragma unroll
        for (int a = 0; a < 2; ++a)
#pragma unroll
            for (int b = 0; b < 2; ++b)
#pragma unroll
                for (int m = 0; m < 4; ++m)
#pragma unroll
                    for (int n = 0; n < 2; ++n) acc[a][b][m][n] = (f32x4){0.f, 0.f, 0.f, 0.f};
        cur = nxt; cA = nA; cB = nB; ++ui;
        if (wr == 1) PG8_BAR;
    }
    PG8_WAIT_V(0);
    PG8_BAR;
#undef PG8_SA
#undef PG8_SB
#undef PG8_STAGE
#undef PG8_LDA
#undef PG8_LDB
#undef PG8_MMA
#undef PG8_WAIT_V
#undef PG8_WAIT_L
#undef PG8_BAR
#undef PG8_SCHED
}

typedef const f32x4 (&AccRef)[2][2][4][2];
__device__ __forceinline__ u32x4 pack8(f32x4 v0, f32x4 v1) { u32x4 w; w.x = pk2(v0[0], v0[1]); w.y = pk2(v0[2], v0[3]); w.z = pk2(v1[0], v1[1]); w.w = pk2(v1[2], v1[3]); return w; }

struct EpiSwiGLU {
    static constexpr bool PERM = true; bf16_t* O;
    __device__ __forceinline__ void operator()(AccRef acc, const Unit& u, int wr, int wc, int fr, int fq) const {
        const int row0 = u.pm * BM + wr * 64 + fr, col0 = u.pn * 128 + wc * 32 + 8 * fq;
#pragma unroll
        for (int ai = 0; ai < 2; ++ai)
#pragma unroll
            for (int m = 0; m < 4; ++m) { bf16_t* rowp = O + (size_t)(row0 + ai * HALF + m * 16) * FF + col0;
                f32x4 v0, v1;
#pragma unroll
                for (int e = 0; e < 4; ++e) { v0[e] = silu_f(acc[ai][0][m][0][e]) * acc[ai][1][m][0][e]; v1[e] = silu_f(acc[ai][0][m][1][e]) * acc[ai][1][m][1][e]; }
                *(u32x4*)rowp = pack8(v0, v1); }
    }
};
struct EpiRes {
    static constexpr bool PERM = false; const float* base; float* out; const float* gate; float gmul;
    __device__ __forceinline__ void operator()(AccRef acc, const Unit& u, int wr, int wc, int fr, int fq) const {
        const int row0 = u.pm * BM + wr * 64 + fr, col0 = u.pn * BM + wc * 32 + 4 * fq;
        const float* gp = gate + (size_t)(u.pm >> 4) * NMODV + col0;
        f32x4 gv[2][2];
#pragma unroll
        for (int bj = 0; bj < 2; ++bj)
#pragma unroll
            for (int n = 0; n < 2; ++n) gv[bj][n] = *(const f32x4*)(gp + bj * HALF + n * 16) * gmul;
#pragma unroll
        for (int ai = 0; ai < 2; ++ai)
#pragma unroll
            for (int m = 0; m < 4; ++m) { const size_t off = (size_t)(row0 + ai * HALF + m * 16) * D + col0;
#pragma unroll
                for (int bj = 0; bj < 2; ++bj)
#pragma unroll
                    for (int n = 0; n < 2; ++n) { const f32x4 bs = *(const f32x4*)(base + off + bj * HALF + n * 16); *(f32x4*)(out + off + bj * HALF + n * 16) = bs + gv[bj][n] * acc[ai][bj][m][n]; } }
    }
};
struct EpiRet {
    static constexpr bool PERM = true; bf16_t *RQ, *RK, *RV, *RG; const float *COS, *SIN;
    __device__ __forceinline__ void operator()(AccRef acc, const Unit& u, int wr, int wc, int fr, int fq) const {
        const int row0 = u.pm * BM + wr * 64 + fr, i0 = wc * 32 + 8 * fq;
        if (u.pn < 16) {
            bf16_t* dst = (u.pn < 8 ? RQ : RK) + (u.pn & 7) * 256 + i0; const float sc = u.pn < 8 ? 0.0625f : 1.0f;
#pragma unroll
            for (int ai = 0; ai < 2; ++ai)
#pragma unroll
                for (int m = 0; m < 4; ++m) { const int r = row0 + ai * HALF + m * 16;
                    const f32x4 c0 = *(const f32x4*)(COS + (size_t)r * 128 + i0), c1 = *(const f32x4*)(COS + (size_t)r * 128 + i0 + 4);
                    const f32x4 s0 = *(const f32x4*)(SIN + (size_t)r * 128 + i0), s1 = *(const f32x4*)(SIN + (size_t)r * 128 + i0 + 4);
                    const f32x4 x10 = acc[ai][0][m][0], x11 = acc[ai][0][m][1], x20 = acc[ai][1][m][0], x21 = acc[ai][1][m][1];
                    const f32x4 o10 = (x10 * c0 - x20 * s0) * sc, o11 = (x11 * c1 - x21 * s1) * sc, o20 = (x10 * s0 + x20 * c0) * sc, o21 = (x11 * s1 + x21 * c1) * sc;
                    *(u32x4*)(dst + (size_t)r * D) = pack8(o10, o11); *(u32x4*)(dst + (size_t)r * D + 128) = pack8(o20, o21); }
        } else {
            const bool isg = u.pn >= 32; bf16_t* dst = (isg ? RG : RV) + ((u.pn - 16) & 15) * 256 + i0;
#pragma unroll
            for (int ai = 0; ai < 2; ++ai)
#pragma unroll
                for (int m = 0; m < 4; ++m) { bf16_t* rowp = dst + (size_t)(row0 + ai * HALF + m * 16) * 4096;
#pragma unroll
                    for (int bj = 0; bj < 2; ++bj) { f32x4 v0 = acc[ai][bj][m][0], v1 = acc[ai][bj][m][1];
                        if (isg) {
#pragma unroll
                            for (int e = 0; e < 4; ++e) { v0[e] = silu_f(v0[e]); v1[e] = silu_f(v1[e]); } }
                        *(u32x4*)(rowp + bj * HALF) = pack8(v0, v1); } }
        }
    }
};
struct EpiLatent {
    static constexpr bool PERM = false; bf16_t* O; const float* g; float* ssq; bf16_t* KR; const float *COS, *SIN;
    __device__ __forceinline__ void operator()(AccRef acc, const Unit& u, int wr, int wc, int fr, int fq) const {
        const int row0 = u.pm * BM + wr * 64 + fr;
        if (u.pn < 2) {
            const int col0 = u.pn * BM + wc * 32 + 4 * fq;
            f32x4 gv[2][2];
#pragma unroll
            for (int bj = 0; bj < 2; ++bj)
#pragma unroll
                for (int n = 0; n < 2; ++n) gv[bj][n] = *(const f32x4*)(g + col0 + bj * HALF + n * 16);
#pragma unroll
            for (int ai = 0; ai < 2; ++ai)
#pragma unroll
                for (int m = 0; m < 4; ++m) { const int r = row0 + ai * HALF + m * 16; float s = 0.f;
#pragma unroll
                    for (int bj = 0; bj < 2; ++bj)
#pragma unroll
                        for (int n = 0; n < 2; ++n) { const f32x4 a = acc[ai][bj][m][n]; s += (a[0] * a[0] + a[1] * a[1]) + (a[2] * a[2] + a[3] * a[3]); const f32x4 v = a * gv[bj][n];
                            u32x2 w; w.x = pk2(v[0], v[1]); w.y = pk2(v[2], v[3]); *(u32x2*)(O + (size_t)r * 512 + col0 + bj * HALF + n * 16) = w; }
                    s += __shfl_xor(s, 16); s += __shfl_xor(s, 32);
                    if (fq == 0) ssq[(size_t)r * 8 + u.pn * 4 + wc] = s; }
        } else if (wc == 0) {
#pragma unroll
            for (int ai = 0; ai < 2; ++ai)
#pragma unroll
                for (int m = 0; m < 4; ++m) { const int r = row0 + ai * HALF + m * 16;
#pragma unroll
                    for (int n = 0; n < 2; ++n) { const int i = 16 * n + 4 * fq;
                        const f32x4 c = *(const f32x4*)(COS + (size_t)r * 32 + i), s = *(const f32x4*)(SIN + (size_t)r * 32 + i);
                        const f32x4 x1 = acc[ai][0][m][n], x2 = acc[ai][1][m][n]; const f32x4 o1 = x1 * c - x2 * s, o2 = x1 * s + x2 * c;
                        u32x2 w1, w2; w1.x = pk2(o1[0], o1[1]); w1.y = pk2(o1[2], o1[3]); w2.x = pk2(o2[0], o2[1]); w2.y = pk2(o2[2], o2[3]);
                        *(u32x2*)(KR + (size_t)r * 64 + i) = w1; *(u32x2*)(KR + (size_t)r * 64 + 32 + i) = w2; } }
        }
    }
};
__device__ __forceinline__ float row_rstd8(const float* ssq, int r, float inv_n) {
    const f32x4 a = *(const f32x4*)(ssq + (size_t)r * 8), b = *(const f32x4*)(ssq + (size_t)r * 8 + 4);
    return __builtin_amdgcn_rsqf(((a[0] + a[1]) + (a[2] + a[3]) + (b[0] + b[1]) + (b[2] + b[3])) * inv_n + EPS);
}
struct EpiUkv {
    static constexpr bool PERM = true; bf16_t *KN, *VV; const float* ssq;
    __device__ __forceinline__ void operator()(AccRef acc, const Unit& u, int wr, int wc, int fr, int fq) const {
        const int row0 = u.pm * BM + wr * 64 + fr, col0 = u.pn * 128 + wc * 32 + 8 * fq;
#pragma unroll
        for (int ai = 0; ai < 2; ++ai)
#pragma unroll
            for (int m = 0; m < 4; ++m) { const int r = row0 + ai * HALF + m * 16; const float rs = row_rstd8(ssq, r, 1.0f / 512.0f);
                *(u32x4*)(KN + (size_t)r * 2048 + col0) = pack8(acc[ai][0][m][0] * rs, acc[ai][0][m][1] * rs);
                *(u32x4*)(VV + (size_t)r * 2048 + col0) = pack8(acc[ai][1][m][0] * rs, acc[ai][1][m][1] * rs); }
    }
};
struct EpiUq {
    static constexpr bool PERM = true; bf16_t* Q; const float* ssq; const float *COS, *SIN; float qscale;
    __device__ __forceinline__ void operator()(AccRef acc, const Unit& u, int wr, int wc, int fr, int fq) const {
        const int row0 = u.pm * BM + wr * 64 + fr;
        if (u.pn < 8) {
            const int col0 = wc * 32 + 8 * fq;
#pragma unroll
            for (int ai = 0; ai < 2; ++ai)
#pragma unroll
                for (int m = 0; m < 4; ++m) { const int r = row0 + ai * HALF + m * 16; const float rs = row_rstd8(ssq, r, 1.0f / 512.0f) * qscale;
#pragma unroll
                    for (int bj = 0; bj < 2; ++bj) *(u32x4*)(Q + (size_t)r * 3072 + (2 * u.pn + bj) * 192 + col0) = pack8(acc[ai][bj][m][0] * rs, acc[ai][bj][m][1] * rs); }
        } else {
            const int head = 4 * (u.pn - 8) + wc, i0 = 8 * fq;
#pragma unroll
            for (int ai = 0; ai < 2; ++ai)
#pragma unroll
                for (int m = 0; m < 4; ++m) { const int r = row0 + ai * HALF + m * 16; const float rs = row_rstd8(ssq, r, 1.0f / 512.0f) * qscale;
                    const f32x4 c0 = *(const f32x4*)(COS + (size_t)r * 32 + i0), c1 = *(const f32x4*)(COS + (size_t)r * 32 + i0 + 4);
                    const f32x4 s0 = *(const f32x4*)(SIN + (size_t)r * 32 + i0), s1 = *(const f32x4*)(SIN + (size_t)r * 32 + i0 + 4);
                    const f32x4 x10 = acc[ai][0][m][0], x11 = acc[ai][0][m][1], x20 = acc[ai][1][m][0], x21 = acc[ai][1][m][1];
                    const f32x4 o10 = (x10 * c0 - x20 * s0) * rs, o11 = (x11 * c1 - x21 * s1) * rs, o20 = (x10 * s0 + x20 * c0) * rs, o21 = (x11 * s1 + x21 * c1) * rs;
                    bf16_t* qp = Q + (size_t)r * 3072 + head * 192 + 128 + i0;
                    *(u32x4*)qp = pack8(o10, o11); *(u32x4*)(qp + 32) = pack8(o20, o21); }
        }
    }
};
}

#define XB_TMO      128
#define XB_XCNT(j)  (256  + 64 * (j))
#define XB_XSUB(j)  (1280 + 64 * (j))
#define XB_XGEN(j)  (2304 + 64 * (j))
#define XB_TOP      3328
#define XB_TOPGEN   3392
#define XCD_BAR_WORDS 3456
#define XB_SPIN_CAP (1u << 20)
__device__ __forceinline__ unsigned xb_ld(unsigned* p)              { return __hip_atomic_load(p, __ATOMIC_RELAXED, __HIP_MEMORY_SCOPE_AGENT); }
__device__ __forceinline__ unsigned xb_add(unsigned* p, unsigned v) { return __hip_atomic_fetch_add(p, v, __ATOMIC_RELAXED, __HIP_MEMORY_SCOPE_AGENT); }
__device__ __forceinline__ unsigned xb_xcc_id() { return (unsigned)__builtin_amdgcn_s_getreg((3 << 11) | 20) & 0xFu; }
#define XB_SPIN(cond, bar) do { unsigned _sp = 0; while (cond) { __builtin_amdgcn_s_sleep(1); \
    if ((++_sp & 255u) == 0u) { if (xb_ld(&(bar)[XB_TMO])) break; if (_sp > XB_SPIN_CAP) { atomicAdd(&(bar)[XB_TMO], 1u); break; } } } } while (0)
struct XcdBarrier { unsigned* bar; unsigned x; volatile LAS unsigned* st; };
__device__ __forceinline__ XcdBarrier xcd_barrier_post(unsigned* bar, volatile LAS unsigned* st) {
    XcdBarrier b; b.bar = bar; b.x = xb_xcc_id(); b.st = st;
    if (threadIdx.x == 0) (void)xb_add(&bar[XB_XCNT(b.x)], 1u);
    return b;
}
__device__ __forceinline__ void xcd_barrier_complete(unsigned* bar, unsigned x, unsigned& nloc, unsigned& nx) {
    const unsigned G = gridDim.x * gridDim.y * gridDim.z;
    unsigned sum, cnt, mine, sp = 0u;
    for (;;) {
        sum = 0u; cnt = 0u; mine = 0u;
#pragma unroll
        for (unsigned j = 0; j < 16; ++j) { const unsigned c = xb_ld(&bar[XB_XCNT(j)]); sum += c; cnt += (c > 0u) ? 1u : 0u; mine = (j == x) ? c : mine; }
        if (sum == G) break;
        __builtin_amdgcn_s_sleep(1);
        if ((++sp & 255u) == 0u) { if (xb_ld(&bar[XB_TMO])) break; if (sp > XB_SPIN_CAP) { atomicAdd(&bar[XB_TMO], 1u); break; } }
    }
    nloc = mine > 0u ? mine : 1u; nx = cnt > 0u ? cnt : 1u;
}
__device__ __forceinline__ void xcd_barrier(const XcdBarrier& b) {
    asm volatile("s_waitcnt vmcnt(0)" ::: "memory");
    __syncthreads();
    if (threadIdx.x == 0) {
        unsigned* bar = b.bar;
        __builtin_amdgcn_s_waitcnt(0);
        unsigned nloc = b.st[0], nx = b.st[1];
        if (nloc == 0u) { xcd_barrier_complete(bar, b.x, nloc, nx); b.st[0] = nloc; b.st[1] = nx; }
        const unsigned old = xb_add(&bar[XB_XSUB(b.x)], 1u);
        const unsigned gen = old / nloc;
        if (old + 1u == (gen + 1u) * nloc) {
            __builtin_amdgcn_fence(__ATOMIC_RELEASE, "agent");
            asm volatile("s_waitcnt vmcnt(0)" ::: "memory");
            const unsigned og = xb_add(&bar[XB_TOP], 1u);
            const unsigned tg = og / nx;
            if (og + 1u == (tg + 1u) * nx) xb_add(&bar[XB_TOPGEN], 1u);
            else XB_SPIN(xb_ld(&bar[XB_TOPGEN]) == tg, bar);
            __builtin_amdgcn_fence(__ATOMIC_ACQUIRE, "agent");
            xb_add(&bar[XB_XGEN(b.x)], 1u);
            asm volatile("s_waitcnt vmcnt(0)" ::: "memory");
        } else {
            XB_SPIN(xb_ld(&bar[XB_XGEN(b.x)]) == gen, bar);
            __builtin_amdgcn_fence(__ATOMIC_ACQUIRE, "agent");
            asm volatile("s_waitcnt vmcnt(0)" ::: "memory");
        }
    }
    __syncthreads();
}

struct Ctx { LAS unsigned char* lds; int tid, lane, wave, vcu, G; };

__device__ __forceinline__ int mods_index(int n, int b) {
    if (n < NMODV) return b * NMODV + n;
    if (n < 2 * NMODV) return (4 + b) * NMODV + (n - NMODV);
    return MODS_KV + b * 2 * D + (n - 2 * NMODV);
}
__device__ __forceinline__ void mods_item(const Ctx& C, int item, const float* ada_w, const float* kv_ada_w, float* modsp) {
    const int cb = item % (NCOLS_MODS / 32), ks = item / (NCOLS_MODS / 32), n0 = cb * 32;
    const float* W; int ldw, col;
    if (n0 < NMODV) { W = ada_w; ldw = NMODV; col = n0; } else if (n0 < 2 * NMODV) { W = ada_w + (size_t)D * NMODV; ldw = NMODV; col = n0 - NMODV; } else { W = kv_ada_w; ldw = 2 * D; col = n0 - 2 * NMODV; }
    const int kr = C.lane >> 3, c4 = 4 * (C.lane & 7);
    const LAS float* cact = (const LAS float*)C.lds;
    f32x4 a0 = {0.f, 0.f, 0.f, 0.f}, a1 = a0, a2 = a0, a3 = a0;
    const float* wp = W + (size_t)(ks * 256 + kr) * ldw + col + c4;
#pragma unroll 8
    for (int it = 0; it < 32; ++it) { const f32x4 w = *(const f32x4*)(wp + (size_t)it * 8 * ldw); const int k = ks * 256 + it * 8 + kr;
        a0 += w * cact[k]; a1 += w * cact[2048 + k]; a2 += w * cact[4096 + k]; a3 += w * cact[6144 + k]; }
#pragma unroll
    for (int e = 0; e < 4; ++e) {
#pragma unroll
        for (int o = 8; o < 64; o <<= 1) { a0[e] += __shfl_xor(a0[e], o); a1[e] += __shfl_xor(a1[e], o); a2[e] += __shfl_xor(a2[e], o); a3[e] += __shfl_xor(a3[e], o); } }
    if (C.lane < 8) { float* o = modsp + (size_t)ks * MODS_TOTAL;
        *(f32x4*)(o + mods_index(n0 + c4, 0)) = a0; *(f32x4*)(o + mods_index(n0 + c4, 1)) = a1; *(f32x4*)(o + mods_index(n0 + c4, 2)) = a2; *(f32x4*)(o + mods_index(n0 + c4, 3)) = a3; }
}
__device__ __forceinline__ void transpose_tile(const float* W, int K, int N, bf16* WT, int k0, int n0, int drow0, LAS float* scr, int lane) {
#pragma unroll 8
    for (int i = 0; i < 32; ++i) { const int kk = 2 * i + (lane >> 5); scr[kk * 33 + (lane & 31)] = W[(size_t)(k0 + kk) * N + n0 + (lane & 31)]; }
    LDS_WAIT(); asm volatile("" ::: "memory");
    const int c = lane & 7;
#pragma unroll
    for (int j = 0; j < 4; ++j) { const int n = (lane >> 3) + 8 * j; const LAS float* s = scr + (8 * c) * 33 + n;
        u32x4 o; o.x = pk2(s[0 * 33], s[1 * 33]); o.y = pk2(s[2 * 33], s[3 * 33]); o.z = pk2(s[4 * 33], s[5 * 33]); o.w = pk2(s[6 * 33], s[7 * 33]);
        *(GAS u32x4*)(WT + (size_t)(drow0 + n) * K + k0 + 8 * c) = o; }
    LDS_WAIT(); asm volatile("" ::: "memory");
}
enum MapKind { MAP_ID = 0, MAP_FFI = 1, MAP_DKV = 2, MAP_UQ = 3 };
__device__ __forceinline__ int map_row(int kind, int n0) {
    if (kind == MAP_FFI) { const int half = n0 >= FF ? 1 : 0, j = n0 - half * FF; return 256 * (j >> 7) + 128 * half + (j & 127); }
    if (kind == MAP_DKV) { return n0 < 544 ? n0 : 640 + (n0 - 544); }
    if (kind == MAP_UQ) { const int head = n0 / 192, d = n0 % 192; if (d < 128) return (head >> 1) * 256 + (head & 1) * 128 + d;
        const int i = d - 128; return 2048 + (head >> 2) * 256 + (i >> 5) * 128 + (head & 3) * 32 + (i & 31); }
    return n0;
}
__device__ __forceinline__ void cvt_item(const float* W, int K, int N, bf16* WT, int kind, int r, LAS float* scr, int lane) {
    const int nblk = N / 32, kb = r / nblk, nb = r % nblk;
    transpose_tile(W, K, N, WT, 64 * kb, 32 * nb, map_row(kind, 32 * nb), scr, lane);
}
__device__ __forceinline__ void sincos_acc(float ang, float& c, float& s) {
    const double x = (double)ang; const double n = __builtin_rint(x * 0.63661977236758134308);
    double r = __builtin_fma(-n, 1.57079632679489655800, x); r = __builtin_fma(-n, 6.12323399573676603587e-17, r);
    const double r2 = r * r;
    double sp = 1.0 / 6227020800.0; sp = sp * r2 - 1.0 / 39916800.0; sp = sp * r2 + 1.0 / 362880.0; sp = sp * r2 - 1.0 / 5040.0; sp = sp * r2 + 1.0 / 120.0; sp = sp * r2 - 1.0 / 6.0; sp = sp * r2 + 1.0; sp *= r;
    double cp = -1.0 / 87178291200.0; cp = cp * r2 + 1.0 / 479001600.0; cp = cp * r2 - 1.0 / 3628800.0; cp = cp * r2 + 1.0 / 40320.0; cp = cp * r2 - 1.0 / 720.0; cp = cp * r2 + 1.0 / 24.0; cp = cp * r2 - 0.5; cp = cp * r2 + 1.0;
    const int q = ((int)n) & 3;
    const double cc = (q == 0) ? cp : (q == 1) ? -sp : (q == 2) ? -cp : sp;
    const double ss = (q == 0) ? sp : (q == 1) ? cp : (q == 2) ? -sp : -cp;
    c = (float)cc; s = (float)ss;
}

__device__ __forceinline__ void norm_phase(const Ctx& C, const float* X, const float* g, const float* shift, const float* scale, int bstride, bf16* H) {
    const int gw = C.vcu * 8 + C.wave, NGW = C.G * 8;
    for (int m0 = gw * 8; m0 < M; m0 += NGW * 8) {
        const int b = m0 >> 12;
        f32x4 gs[8], sh[8];
#pragma unroll
        for (int j = 0; j < 8; ++j) { const int c = 4 * C.lane + 256 * j; const f32x4 gg = *(const f32x4*)(g + c), sc = *(const f32x4*)(scale + (size_t)b * bstride + c);
            gs[j] = gg * (sc + 1.0f); sh[j] = *(const f32x4*)(shift + (size_t)b * bstride + c); }
        for (int r = 0; r < 8; ++r) {
            const GAS f32x4* xr = (const GAS f32x4*)(X + (size_t)(m0 + r) * D) + C.lane;
            f32x4 v[8]; float s = 0.f;
#pragma unroll
            for (int j = 0; j < 8; ++j) { v[j] = xr[64 * j]; s += (v[j].x * v[j].x + v[j].y * v[j].y) + (v[j].z * v[j].z + v[j].w * v[j].w); }
            const float rstd = __builtin_amdgcn_rsqf(wave_sum(s) * (1.0f / D) + EPS);
            GAS u32x2* o8 = (GAS u32x2*)(H + (size_t)(m0 + r) * D) + C.lane;
#pragma unroll
            for (int j = 0; j < 8; ++j) { const f32x4 y = v[j] * rstd * gs[j] + sh[j]; u32x2 w; w.x = pk2(y.x, y.y); w.y = pk2(y.z, y.w); o8[64 * j] = w; }
        }
    }
}
__device__ __forceinline__ void final_norm_phase(const Ctx& C, float* X, const float* g) {
    const int gw = C.vcu * 8 + C.wave, NGW = C.G * 8;
    f32x4 gs[8];
#pragma unroll
    for (int j = 0; j < 8; ++j) gs[j] = *(const f32x4*)(g + 4 * C.lane + 256 * j);
    for (int m = gw; m < M; m += NGW) {
        GAS f32x4* xr = (GAS f32x4*)(X + (size_t)m * D) + C.lane;
        f32x4 v[8]; float s = 0.f;
#pragma unroll
        for (int j = 0; j < 8; ++j) { v[j] = xr[64 * j]; s += (v[j].x * v[j].x + v[j].y * v[j].y) + (v[j].z * v[j].z + v[j].w * v[j].w); }
        const float rstd = __builtin_amdgcn_rsqf(wave_sum(s) * (1.0f / D) + EPS);
#pragma unroll
        for (int j = 0; j < 8; ++j) xr[64 * j] = v[j] * rstd * gs[j];
    }
}

namespace ret {
constexpr int PQ = 528, PV = 272;
constexpr int QI = 0, KI = 64 * PQ, ST = 2 * 64 * PQ, VI = 3 * 64 * PQ, RED = VI + 64 * PV, RET_LDS = RED + 16384;
static_assert(RET_LDS <= RING_BYTES, "retention LDS");
__device__ __forceinline__ s16x4 trd(const LAS unsigned char* p) { return __builtin_bit_cast(s16x4, __builtin_amdgcn_ds_read_tr16_b64_v4i16((LAS v4i16_t*)p)); }
__device__ __forceinline__ bf16x8 cat(s16x4 lo, s16x4 hi) { return (bf16x8){lo[0], lo[1], lo[2], lo[3], hi[0], hi[1], hi[2], hi[3]}; }
#define MFMA16(a, b, c) __builtin_amdgcn_mfma_f32_16x16x32_bf16((a), (b), (c), 0, 0, 0)

__device__ __forceinline__ void retention_phase(const Ctx& C, const bf16* RQ, const bf16* RK, const bf16* RV, bf16* RO, float* RSTAT) {
    LAS unsigned char* lds = C.lds;
    const int tid = C.tid, lane = C.lane, w = C.wave, l15 = lane & 15, quad = lane >> 4, q4 = (lane & 15) >> 2, p4 = lane & 3;
    const int ci = w & 3, rh = w >> 2;
    const LAS unsigned char* bQ  = lds + QI + (16 * ci + l15) * PQ + quad * 16;
    const LAS unsigned char* bK  = lds + KI + (32 * rh + l15) * PQ + quad * 16;
    const LAS unsigned char* bS  = lds + ST + l15 * PQ + quad * 16;
    const LAS unsigned char* bV1 = lds + VI + (32 * rh + 4 * quad + q4) * PV + p4 * 8;
    const LAS unsigned char* bK2 = lds + KI + (8 * quad + q4) * PQ + (32 * w + 4 * p4) * 2;
    const LAS unsigned char* bV2 = lds + VI + (8 * quad + q4) * PV + p4 * 8 + 128;
    LAS unsigned char* bSW = lds + ST + l15 * PQ + (32 * w + 4 * quad) * 2;
    LAS unsigned char* bR  = lds + RED + ci * 4096 + lane * 4;
    LAS unsigned char* bSt = lds + (tid >> 5) * PQ + (tid & 31) * 16;
    const int vrow = tid >> 3, vch = tid & 7;
    LAS unsigned char* bVs = lds + VI + vrow * PV + vch * 16;
    for (int unit = C.vcu; unit < 256; unit += C.G) {
        const int b = unit >> 6, h = (unit >> 3) & 7, vs = unit & 7;
        const float log2g = __builtin_log2f(1.0f - __builtin_exp2f(-5.0f - (float)h));
        const float gchunk = __builtin_exp2f(log2g * 64.0f);
        float fdec[2][4];
        const int iq = 16 * ci + l15;
#pragma unroll
        for (int jt = 0; jt < 2; ++jt)
#pragma unroll
            for (int e = 0; e < 4; ++e) { const int j = 32 * rh + 16 * jt + 4 * quad + e; const int d = (iq > j ? iq - j : j - iq) - (iq + 1); fdec[jt][e] = __builtin_exp2f(log2g * (float)d); }
        const float xi = __builtin_exp2f(log2g * (float)(iq + 1));
        const float zeta = __builtin_exp2f(log2g * (float)(63 - vrow));
        __syncthreads();
        for (int i = tid; i < 64 * PQ / 16; i += 512) *(LAS u32x4*)(lds + ST + i * 16) = (u32x4){0u, 0u, 0u, 0u};
        f32x4 st[2][4];
#pragma unroll
        for (int mt = 0; mt < 2; ++mt)
#pragma unroll
            for (int nt = 0; nt < 4; ++nt) st[mt][nt] = (f32x4){0.f, 0.f, 0.f, 0.f};
        const size_t tok0 = (size_t)b * SEQ;
        const bf16* qg = RQ + (tok0 + (tid >> 5)) * D + h * 256 + (tid & 31) * 8; const bf16* kg = RK + (tok0 + (tid >> 5)) * D + h * 256 + (tid & 31) * 8;
        const bf16* vg = RV + (tok0 + vrow) * 4096 + h * 512 + vs * 64 + vch * 8;
        u32x4 qreg[4], kreg[4], vreg;
#define RET_LOAD(c) do { const size_t t0_ = (size_t)(c) * 64; _Pragma("unroll") for (int i = 0; i < 4; ++i) { \
            qreg[i] = *(const GAS u32x4*)(qg + (t0_ + 16 * i) * D); kreg[i] = *(const GAS u32x4*)(kg + (t0_ + 16 * i) * D); } \
            vreg = *(const GAS u32x4*)(vg + t0_ * 4096); } while (0)
#define RET_STORE() do { _Pragma("unroll") for (int i = 0; i < 4; ++i) { *(LAS u32x4*)(bSt + QI + 16 * i * PQ) = qreg[i]; *(LAS u32x4*)(bSt + KI + 16 * i * PQ) = kreg[i]; } \
            *(LAS u32x4*)(bVs) = vreg; \
            u32x4 vz; vz.x = pk2(bf_lo(vreg.x) * zeta, bf_hi(vreg.x) * zeta); vz.y = pk2(bf_lo(vreg.y) * zeta, bf_hi(vreg.y) * zeta); vz.z = pk2(bf_lo(vreg.z) * zeta, bf_hi(vreg.z) * zeta); vz.w = pk2(bf_lo(vreg.w) * zeta, bf_hi(vreg.w) * zeta); \
            *(LAS u32x4*)(bVs + 128) = vz; } while (0)
        RET_LOAD(0);
        RET_STORE();
        RET_LOAD(1);
#pragma unroll 1
        for (int c = 0; c < 64; ++c) {
            __syncthreads();
            f32x4 sT[2] = {(f32x4){0.f, 0.f, 0.f, 0.f}, (f32x4){0.f, 0.f, 0.f, 0.f}};
            f32x4 acc[4];
#pragma unroll
            for (int t = 0; t < 4; ++t) acc[t] = (f32x4){0.f, 0.f, 0.f, 0.f};
#pragma unroll
            for (int s = 0; s < 8; ++s) {
                const bf16x8 qf = *(const LAS bf16x8*)(bQ + 64 * s);
#pragma unroll
                for (int jt = 0; jt < 2; ++jt) { const bf16x8 kf = *(const LAS bf16x8*)(bK + 16 * jt * PQ + 64 * s); sT[jt] = MFMA16(kf, qf, sT[jt]); }
                if ((s >> 2) == rh) {
#pragma unroll
                    for (int t = 0; t < 4; ++t) { const bf16x8 sf = *(const LAS bf16x8*)(bS + 16 * t * PQ + 64 * s); acc[t] = MFMA16(sf, qf, acc[t]); }
                }
            }
            u32x4 pw; pw.x = pk2(sT[0][0] * fdec[0][0], sT[0][1] * fdec[0][1]); pw.y = pk2(sT[0][2] * fdec[0][2], sT[0][3] * fdec[0][3]);
            pw.z = pk2(sT[1][0] * fdec[1][0], sT[1][1] * fdec[1][1]); pw.w = pk2(sT[1][2] * fdec[1][2], sT[1][3] * fdec[1][3]);
            const bf16x8 pf = __builtin_bit_cast(bf16x8, pw);
#pragma unroll
            for (int t = 0; t < 4; ++t) {
                const s16x4 lo = trd(bV1 + 32 * t), hi = trd(bV1 + 16 * PV + 32 * t);
                acc[t] = MFMA16(cat(lo, hi), pf, acc[t]);
            }
#pragma unroll
            for (int mt = 0; mt < 2; ++mt)
#pragma unroll
                for (int nt = 0; nt < 4; ++nt) st[mt][nt] *= gchunk;
#pragma unroll
            for (int ks = 0; ks < 2; ++ks) {
                bf16x8 af[2], bfv[4];
#pragma unroll
                for (int mt = 0; mt < 2; ++mt) af[mt] = cat(trd(bK2 + (32 * ks) * PQ + 32 * mt), trd(bK2 + (32 * ks + 4) * PQ + 32 * mt));
#pragma unroll
                for (int nt = 0; nt < 4; ++nt) bfv[nt] = cat(trd(bV2 + (32 * ks) * PV + 32 * nt), trd(bV2 + (32 * ks + 4) * PV + 32 * nt));
#pragma unroll
                for (int mt = 0; mt < 2; ++mt)
#pragma unroll
                    for (int nt = 0; nt < 4; ++nt) st[mt][nt] = MFMA16(af[mt], bfv[nt], st[mt][nt]);
            }
            if (rh == 1) {
#pragma unroll
                for (int t = 0; t < 4; ++t)
#pragma unroll
                    for (int e = 0; e < 4; ++e) *(LAS float*)(bR + (t * 4 + e) * 256) = acc[t][e];
            }
            __syncthreads();
            if (rh == 0) {
                float s1 = 0.f, s2 = 0.f;
                bf16* op = RO + (tok0 + (size_t)c * 64 + iq) * 4096 + h * 512 + vs * 64 + 4 * quad;
#pragma unroll
                for (int t = 0; t < 4; ++t) { f32x4 o;
#pragma unroll
                    for (int e = 0; e < 4; ++e) { o[e] = (acc[t][e] + *(const LAS float*)(bR + (t * 4 + e) * 256)) * xi; s1 += o[e]; s2 += o[e] * o[e]; }
                    u32x2 wv; wv.x = pk2(o[0], o[1]); wv.y = pk2(o[2], o[3]); *(GAS u32x2*)(op + 16 * t) = wv; }
                s1 += __shfl_xor(s1, 16); s1 += __shfl_xor(s1, 32); s2 += __shfl_xor(s2, 16); s2 += __shfl_xor(s2, 32);
                if (quad == 0) *(GAS f32x2*)(RSTAT + (((tok0 + (size_t)c * 64 + iq) * 8 + h) * 8 + vs) * 2) = (f32x2){s1, s2};
            }
#pragma unroll
            for (int mt = 0; mt < 2; ++mt)
#pragma unroll
                for (int nt = 0; nt < 4; ++nt) { u32x2 wv; wv.x = pk2(st[mt][nt][0], st[mt][nt][1]); wv.y = pk2(st[mt][nt][2], st[mt][nt][3]); *(LAS u32x2*)(bSW + 16 * nt * PQ + 32 * mt) = wv; }
            if (c + 1 < 64) { RET_STORE(); if (c + 2 < 64) RET_LOAD(c + 2); }
        }
#undef RET_LOAD
#undef RET_STORE
    }
    __syncthreads();
}
__device__ __forceinline__ void gate_phase(const Ctx& C, const bf16* RO, bf16* RG, const float* RSTAT, const float* gn_g) {
    const int gw = C.vcu * 8 + C.wave, NGW = C.G * 8;
    for (int m = gw; m < M; m += NGW) {
#pragma unroll
        for (int k = 0; k < 8; ++k) {
            const float* sp = RSTAT + ((size_t)m * 8 + k) * 16; float s1 = 0.f, s2 = 0.f;
#pragma unroll
            for (int j = 0; j < 4; ++j) { const f32x4 v = *(const f32x4*)(sp + 4 * j); s1 += v[0] + v[2]; s2 += v[1] + v[3]; }
            const float mu = s1 * (1.0f / 512.0f), var = s2 * (1.0f / 512.0f) - mu * mu, rstd = __builtin_amdgcn_rsqf(var + EPS);
            const size_t off = (size_t)m * 4096 + 8 * (C.lane + 64 * k);
            const u32x4 ov = *(const GAS u32x4*)(RO + off), gv = *(const GAS u32x4*)(RG + off);
            const f32x4 g0 = *(const f32x4*)(gn_g + 8 * (C.lane + 64 * k)), g1 = *(const f32x4*)(gn_g + 8 * (C.lane + 64 * k) + 4);
            u32x4 r;
            r.x = pk2(bf_lo(gv.x) * (bf_lo(ov.x) - mu) * rstd * g0[0], bf_hi(gv.x) * (bf_hi(ov.x) - mu) * rstd * g0[1]);
            r.y = pk2(bf_lo(gv.y) * (bf_lo(ov.y) - mu) * rstd * g0[2], bf_hi(gv.y) * (bf_hi(ov.y) - mu) * rstd * g0[3]);
            r.z = pk2(bf_lo(gv.z) * (bf_lo(ov.z) - mu) * rstd * g1[0], bf_hi(gv.z) * (bf_hi(ov.z) - mu) * rstd * g1[1]);
            r.w = pk2(bf_lo(gv.w) * (bf_lo(ov.w) - mu) * rstd * g1[2], bf_hi(gv.w) * (bf_hi(ov.w) - mu) * rstd * g1[3]);
            *(GAS u32x4*)(RG + off) = r;
        }
    }
}
}

namespace att {
constexpr int KROW = 400, VROW = 272;
constexpr int KT0 = 0, KBUF = 64 * KROW, VT0 = 2 * KBUF, VBUF = 64 * VROW, ATT_LDS = VT0 + 2 * VBUF;
static_assert(ATT_LDS <= RING_BYTES, "attention LDS");
using ret::trd; using ret::cat;
#define MFMA32(a, b, c) __builtin_amdgcn_mfma_f32_32x32x16_bf16((a), (b), (c), 0, 0, 0)

__device__ __forceinline__ void attention_phase(const Ctx& C, const bf16* QQ, const bf16* KN, const bf16* KR, const bf16* VV, bf16* AO) {
    LAS unsigned char* lds = C.lds;
    const int tid = C.tid, lane = C.lane, w = C.wave, r32 = lane & 31, hi = lane >> 5, blk = (lane >> 4) & 1, q4 = (lane & 15) >> 2, p4 = lane & 3;
    const LAS unsigned char* bK = lds + KT0 + r32 * KROW + 16 * hi;
    const LAS unsigned char* bV = lds + VT0 + (4 * hi + q4) * VROW + blk * 32 + p4 * 8;
    const int vkey = tid >> 4, vch = tid & 15;
    const int rkey = tid >> 3, rch = tid & 7;
    LAS unsigned char* sKN = lds + KT0 + vkey * KROW + vch * 16;
    LAS unsigned char* sKR = lds + KT0 + rkey * KROW + 256 + rch * 16;
    LAS unsigned char* sV  = lds + VT0 + vkey * VROW + vch * 16;
    for (int pair = C.vcu; pair < 512; pair += C.G) {
#pragma unroll 1
        for (int half = 0; half < 2; ++half) {
            const int bh = pair >> 3, pr = pair & 7, qb = half ? 15 - pr : pr, b = bh >> 4, h = bh & 15;
            const size_t tok0 = (size_t)b * SEQ;
            const int NT = 4 * qb + 4, myc = 4 * qb + (w >> 1);
            bf16x8 qf[12];
            { const bf16* qp = QQ + (tok0 + (size_t)qb * 256 + w * 32 + r32) * 3072 + h * 192 + 8 * hi;
#pragma unroll
              for (int s = 0; s < 12; ++s) qf[s] = *(const GAS bf16x8*)(qp + 16 * s); }
            f32x16 o[4];
#pragma unroll
            for (int c = 0; c < 4; ++c)
#pragma unroll
                for (int r = 0; r < 16; ++r) o[c][r] = 0.f;
            float mrun = -1e30f, lsum = 0.f;
            u32x4 kreg[3], vreg[2];
            const unsigned nvoff = (unsigned)vkey * 2048u + h * 128 + vch * 8, roff = (unsigned)rkey * 64u + rch * 8;
            const bf16* knb = KN + tok0 * 2048; const bf16* vvb = VV + tok0 * 2048; const bf16* krb = KR + tok0 * 64;
#define ATT_LOAD(t) do { const bf16* kn_ = knb + (size_t)(t) * 64 * 2048; const bf16* vv_ = vvb + (size_t)(t) * 64 * 2048; const bf16* kr_ = krb + (size_t)(t) * 64 * 64; \
                kreg[0] = *(const GAS u32x4*)(kn_ + nvoff); kreg[1] = *(const GAS u32x4*)(kn_ + nvoff + 32 * 2048); kreg[2] = *(const GAS u32x4*)(kr_ + roff); \
                vreg[0] = *(const GAS u32x4*)(vv_ + nvoff); vreg[1] = *(const GAS u32x4*)(vv_ + nvoff + 32 * 2048); } while (0)
#define ATT_STORE(buf) do { *(LAS u32x4*)(sKN + (buf) * KBUF) = kreg[0]; *(LAS u32x4*)(sKN + (buf) * KBUF + 32 * KROW) = kreg[1]; *(LAS u32x4*)(sKR + (buf) * KBUF) = kreg[2]; \
                *(LAS u32x4*)(sV + (buf) * VBUF) = vreg[0]; *(LAS u32x4*)(sV + (buf) * VBUF + 32 * VROW) = vreg[1]; } while (0)
            ATT_LOAD(0);
            __syncthreads();
            ATT_STORE(0);
            ATT_LOAD(1);
            __syncthreads();
#pragma unroll 1
            for (int t = 0; t < NT; ++t) {
                const int buf = t & 1;
                if (t <= myc) {
                    const LAS unsigned char* kb = bK + buf * KBUF;
                    f32x16 s0, s1;
#pragma unroll
                    for (int r = 0; r < 16; ++r) { s0[r] = 0.f; s1[r] = 0.f; }
#pragma unroll
                    for (int s = 0; s < 12; ++s) { const bf16x8 k0 = *(const LAS bf16x8*)(kb + 32 * s), k1 = *(const LAS bf16x8*)(kb + 32 * KROW + 32 * s);
                        s0 = MFMA32(k0, qf[s], s0); s1 = MFMA32(k1, qf[s], s1); }
                    float mx = s0[0];
#pragma unroll
                    for (int r = 1; r < 16; ++r) mx = __builtin_fmaxf(mx, s0[r]);
#pragma unroll
                    for (int r = 0; r < 16; ++r) mx = __builtin_fmaxf(mx, s1[r]);
                    mx = __builtin_fmaxf(mx, __shfl_xor(mx, 32));
                    const float mnew = __builtin_fmaxf(mrun, mx), alpha = __builtin_amdgcn_exp2f(mrun - mnew); mrun = mnew;
                    float ps = 0.f;
#pragma unroll
                    for (int r = 0; r < 16; ++r) { s0[r] = __builtin_amdgcn_exp2f(s0[r] - mnew); s1[r] = __builtin_amdgcn_exp2f(s1[r] - mnew); ps += s0[r] + s1[r]; }
                    lsum = lsum * alpha + ps;
#pragma unroll
                    for (int c = 0; c < 4; ++c)
#pragma unroll
                        for (int r = 0; r < 16; ++r) o[c][r] *= alpha;
                    bf16x8 pf[4];
                    { u32x4 a; a.x = pk2(s0[0], s0[1]); a.y = pk2(s0[2], s0[3]); a.z = pk2(s0[4], s0[5]); a.w = pk2(s0[6], s0[7]); pf[0] = __builtin_bit_cast(bf16x8, a);
                      a.x = pk2(s0[8], s0[9]); a.y = pk2(s0[10], s0[11]); a.z = pk2(s0[12], s0[13]); a.w = pk2(s0[14], s0[15]); pf[1] = __builtin_bit_cast(bf16x8, a);
                      a.x = pk2(s1[0], s1[1]); a.y = pk2(s1[2], s1[3]); a.z = pk2(s1[4], s1[5]); a.w = pk2(s1[6], s1[7]); pf[2] = __builtin_bit_cast(bf16x8, a);
                      a.x = pk2(s1[8], s1[9]); a.y = pk2(s1[10], s1[11]); a.z = pk2(s1[12], s1[13]); a.w = pk2(s1[14], s1[15]); pf[3] = __builtin_bit_cast(bf16x8, a); }
                    const LAS unsigned char* vb = bV + buf * VBUF;
#pragma unroll
                    for (int s2 = 0; s2 < 4; ++s2)
#pragma unroll
                        for (int c = 0; c < 4; ++c) {
                            const s16x4 lo = trd(vb + (16 * s2) * VROW + 64 * c), hh = trd(vb + (16 * s2 + 8) * VROW + 64 * c);
                            o[c] = MFMA32(cat(lo, hh), pf[s2], o[c]);
                        }
                }
                if (t + 1 < NT) { ATT_STORE(buf ^ 1); if (t + 2 < NT) ATT_LOAD(t + 2); }
                __syncthreads();
            }
            const float linv = 1.0f / (lsum + __shfl_xor(lsum, 32));
            bf16* op = AO + (tok0 + (size_t)qb * 256 + w * 32 + r32) * 2048 + h * 128 + 4 * hi;
#pragma unroll
            for (int c = 0; c < 4; ++c)
#pragma unroll
                for (int g4 = 0; g4 < 4; ++g4) { u32x2 wv; wv.x = pk2(o[c][4 * g4] * linv, o[c][4 * g4 + 1] * linv); wv.y = pk2(o[c][4 * g4 + 2] * linv, o[c][4 * g4 + 3] * linv);
                    *(GAS u32x2*)(op + 32 * c + 8 * g4) = wv; }
#undef ATT_LOAD
#undef ATT_STORE
        }
    }
    __syncthreads();
}
}

struct Args { const float* in[22]; float* out; unsigned char* ws; int ph_lo, ph_hi; };
enum { I_X = 0, I_C, I_POS, I_ADAW, I_ADAB, I_NORMG, I_FFI, I_FFO, I_RWI, I_RGN, I_RWO, I_KVAW, I_KVAB, I_KVNG, I_WDKV, I_KVLG, I_WUKV, I_WDQ, I_QLG, I_WUQ, I_WMO, I_FING };
constexpr int N_PHASES = 28;

__global__ void __launch_bounds__(512, 2) mk_fwd(Args args) {
    extern __shared__ __attribute__((aligned(16))) unsigned char lds_raw[];
    Ctx C;
    C.lds = (LAS unsigned char*)lds_raw;
    C.tid = threadIdx.x; C.lane = C.tid & 63; C.wave = __builtin_amdgcn_readfirstlane(C.tid >> 6);
    C.G = gridDim.x; { const int bx = blockIdx.x; C.vcu = (C.G % 8 == 0) ? (bx % 8) * (C.G / 8) + bx / 8 : bx; }
    unsigned char* ws = args.ws;
    unsigned* ctl = (unsigned*)(ws + WS_CTL);
    volatile LAS unsigned* MISC = (volatile LAS unsigned*)(C.lds + MISC_OFF);
    for (int u = C.tid; u < (LDS_BYTES - LDSCTL_OFF) / 4; u += 512) ((LAS unsigned*)(C.lds + LDSCTL_OFF))[u] = 0u;
    __syncthreads();
    XcdBarrier bar; bar.bar = ctl + CW_BAR; bar.x = 0; bar.st = nullptr;
    if (!MK_PER_PHASE) bar = xcd_barrier_post(ctl + CW_BAR, MISC + 8);
    const int lo = args.ph_lo, hi = args.ph_hi;
#ifndef MK_ONLY
#define MK_ONLY -1
#endif
#define IN(k) ((MK_ONLY < 0 || MK_ONLY == (k)) && lo <= (k) && (k) < hi)
#define SEAM(k) do { if (!MK_PER_PHASE && IN((k) + 1)) xcd_barrier(bar); } while (0)

    const float* x_in = args.in[I_X]; float* X = args.out;
    float* MODSP = (float*)(ws + WS_MODSP); float* MODS = (float*)(ws + WS_MODS);
    float* COSR = (float*)(ws + WS_COSR); float* SINR = (float*)(ws + WS_SINR); float* COSM = (float*)(ws + WS_COSM); float* SINM = (float*)(ws + WS_SINM);
    float* RSTAT = (float*)(ws + WS_RSTAT); float* SSQKV = (float*)(ws + WS_SSQKV); float* SSQQ = (float*)(ws + WS_SSQQ);
    bf16* WFI = (bf16*)(ws + WS_WFI); bf16* WFO = (bf16*)(ws + WS_WFO); bf16* WRI = (bf16*)(ws + WS_WRI); bf16* WRO = (bf16*)(ws + WS_WRO);
    bf16* WDKV = (bf16*)(ws + WS_WDKV); bf16* WUKV = (bf16*)(ws + WS_WUKV); bf16* WDQ = (bf16*)(ws + WS_WDQ); bf16* WUQ = (bf16*)(ws + WS_WUQ); bf16* WMO = (bf16*)(ws + WS_WMO);
    bf16* H = (bf16*)(ws + WS_H); bf16* HK = (bf16*)(ws + WS_HK); bf16* A = (bf16*)(ws + WS_A);
    bf16* RQ = (bf16*)(ws + WS_RQ); bf16* RK = (bf16*)(ws + WS_RK); bf16* RV = (bf16*)(ws + WS_RV); bf16* RG = (bf16*)(ws + WS_RG); bf16* RO = (bf16*)(ws + WS_RO);
    bf16* CKVG = (bf16*)(ws + WS_CKVG); bf16* CQG = (bf16*)(ws + WS_CQG); bf16* KR = (bf16*)(ws + WS_KR); bf16* KN = (bf16*)(ws + WS_KN); bf16* VV = (bf16*)(ws + WS_VV);
    bf16* QQ = (bf16*)(ws + WS_QQ); bf16* AO = (bf16*)(ws + WS_AO);
    const float* norm_g = args.in[I_NORMG];

    if (IN(0)) {
        { const float* c = args.in[I_C]; LAS float* cact = (LAS float*)C.lds; for (int i = C.tid; i < 4 * D; i += 512) cact[i] = silu_f(c[i]); }
        __syncthreads();
        const int gw = C.vcu * 8 + C.wave, NGW = C.G * 8;
        constexpr int N_MODS_ITEMS = (NCOLS_MODS / 32) * 8;
        for (int it = gw; it < N_MODS_ITEMS; it += NGW) mods_item(C, it, args.in[I_ADAW], args.in[I_KVAW], MODSP);
        LAS float* scr = (LAS float*)(C.lds + 32768 + C.wave * 8448);
        constexpr int I_FI = (D / 64) * (2 * FF / 32), I_FO = (FF / 64) * (D / 32), I_RI = (D / 64) * (RIN / 32), I_RO = (4096 / 64) * (D / 32), I_DKV = (D / 64) * (576 / 32),
                      I_UKV = (512 / 64) * (4096 / 32), I_DQ = (D / 64) * (512 / 32), I_UQ = (512 / 64) * (3072 / 32), I_MO = (D / 64) * (D / 32);
        constexpr int NITEMS = 4 * I_FI + 4 * I_FO + I_RI + I_RO + I_DKV + I_UKV + I_DQ + I_UQ + I_MO;
        for (int it = gw; it < NITEMS; it += NGW) {
            int r = it;
            if (r < 4 * I_FI) { const int q = r / I_FI; cvt_item(args.in[I_FFI] + (size_t)q * D * 2 * FF, D, 2 * FF, WFI + (size_t)q * WFI_ELEMS, MAP_FFI, r % I_FI, scr, C.lane); continue; } r -= 4 * I_FI;
            if (r < 4 * I_FO) { const int q = r / I_FO; cvt_item(args.in[I_FFO] + (size_t)q * FF * D, FF, D, WFO + (size_t)q * WFO_ELEMS, MAP_ID, r % I_FO, scr, C.lane); continue; } r -= 4 * I_FO;
            if (r < I_RI) { cvt_item(args.in[I_RWI], D, RIN, WRI, MAP_ID, r, scr, C.lane); continue; } r -= I_RI;
            if (r < I_RO) { cvt_item(args.in[I_RWO], 4096, D, WRO, MAP_ID, r, scr, C.lane); continue; } r -= I_RO;
            if (r < I_DKV) { cvt_item(args.in[I_WDKV], D, 576, WDKV, MAP_DKV, r, scr, C.lane); continue; } r -= I_DKV;
            if (r < I_UKV) { cvt_item(args.in[I_WUKV], 512, 4096, WUKV, MAP_ID, r, scr, C.lane); continue; } r -= I_UKV;
            if (r < I_DQ) { cvt_item(args.in[I_WDQ], D, 512, WDQ, MAP_ID, r, scr, C.lane); continue; } r -= I_DQ;
            if (r < I_UQ) { cvt_item(args.in[I_WUQ], 512, 3072, WUQ, MAP_UQ, r, scr, C.lane); continue; } r -= I_UQ;
            cvt_item(args.in[I_WMO], D, D, WMO, MAP_ID, r, scr, C.lane);
        }
        { const int gt = C.vcu * 512 + C.tid, NGT = C.G * 512;
          for (int i = gt; i < 192 * 256; i += NGT) { const int rr = i >> 8, c16 = i & 255; const int row = rr < 96 ? 544 + rr : 672 + (rr - 96); *(GAS u32x4*)(WDKV + (size_t)row * D + c16 * 8) = (u32x4){0u, 0u, 0u, 0u}; }
          const int* pos = (const int*)args.in[I_POS];
          for (int i = gt; i < M * 128; i += NGT) { const int m = i >> 7, j = i & 127; const float inv = (float)exp2(-(double)j * (13.287712379549449 / 128.0)); float cc, ss; sincos_acc((float)pos[m] * inv, cc, ss); COSR[i] = cc; SINR[i] = ss; }
          for (int i = gt; i < M * 32; i += NGT) { const int m = i >> 5, j = i & 31; const float inv = (float)exp2(-(double)j * (13.287712379549449 / 32.0)); float cc, ss; sincos_acc((float)pos[m] * inv, cc, ss); COSM[i] = cc; SINM[i] = ss; }
        }
        SEAM(0);
    }
    if (IN(1)) {
        const int gt = C.vcu * 512 + C.tid, NGT = C.G * 512;
        for (int i = gt; i < MODS_TOTAL; i += NGT) { float s = 0.f;
#pragma unroll
            for (int k = 0; k < 8; ++k) s += MODSP[(size_t)k * MODS_TOTAL + i];
            float bias; if (i < MODS_KV) { const int l = i / (4 * NMODV), n = i % NMODV; bias = args.in[I_ADAB][l * NMODV + n]; } else { bias = args.in[I_KVAB][(i - MODS_KV) % (2 * D)]; }
            MODS[i] = s + bias; }
        SEAM(1);
    }
#define MODL(l, k) (MODS + (size_t)(l) * 4 * NMODV + (size_t)(k) * D)
#define GEMM(Aop, Bop, N_, K_, EpiT, ...) do { pg8::Gemm g_{(Aop), (Bop), M, (N_), (K_)}; pg8::StaticOrder S_; S_.init(M, (N_), C.G, (int)blockIdx.x); pg8::EpiT E_{__VA_ARGS__}; \
        pg8::gemm_phase<pg8::EpiT, pg8::StaticOrder>(C.lds, g_, S_, E_); } while (0)

    if (IN(2)) { norm_phase(C, x_in, norm_g + 0 * D, MODL(0, 0), MODL(0, 1), NMODV, H); SEAM(2); }
    if (IN(3)) { GEMM(H, WFI + 0 * WFI_ELEMS, 2 * FF, D, EpiSwiGLU, A); SEAM(3); }
    if (IN(4)) { GEMM(A, WFO + 0 * WFO_ELEMS, D, FF, EpiRes, x_in, X, MODL(0, 2), 0.5f); SEAM(4); }
    if (IN(5)) { norm_phase(C, X, norm_g + 1 * D, MODL(0, 3), MODL(0, 4), NMODV, H); SEAM(5); }
    if (IN(6)) { GEMM(H, WRI, RIN, D, EpiRet, RQ, RK, RV, RG, COSR, SINR); SEAM(6); }
    if (IN(7)) { ret::retention_phase(C, RQ, RK, RV, RO, RSTAT); SEAM(7); }
    if (IN(8)) { ret::gate_phase(C, RO, RG, RSTAT, args.in[I_RGN]); SEAM(8); }
    if (IN(9)) { GEMM(RG, WRO, D, 4096, EpiRes, X, X, MODL(0, 5), 1.0f); SEAM(9); }
    if (IN(10)) { norm_phase(C, X, norm_g + 2 * D, MODL(0, 6), MODL(0, 7), NMODV, H); SEAM(10); }
    if (IN(11)) { GEMM(H, WFI + 1 * WFI_ELEMS, 2 * FF, D, EpiSwiGLU, A); SEAM(11); }
    if (IN(12)) { GEMM(A, WFO + 1 * WFO_ELEMS, D, FF, EpiRes, X, X, MODL(0, 8), 0.5f); SEAM(12); }
    if (IN(13)) { norm_phase(C, X, args.in[I_KVNG], MODS + MODS_KV, MODS + MODS_KV + D, 2 * D, HK);
                  norm_phase(C, X, norm_g + 3 * D, MODL(1, 0), MODL(1, 1), NMODV, H); SEAM(13); }
    if (IN(14)) { GEMM(HK, WDKV, 768, D, EpiLatent, CKVG, args.in[I_KVLG], SSQKV, KR, COSM, SINM); SEAM(14); }
    if (IN(15)) { GEMM(CKVG, WUKV, 4096, 512, EpiUkv, KN, VV, SSQKV);
                  GEMM(H, WFI + 2 * WFI_ELEMS, 2 * FF, D, EpiSwiGLU, A); SEAM(15); }
    if (IN(16)) { GEMM(A, WFO + 2 * WFO_ELEMS, D, FF, EpiRes, X, X, MODL(1, 2), 0.5f); SEAM(16); }
    if (IN(17)) { norm_phase(C, X, norm_g + 4 * D, MODL(1, 3), MODL(1, 4), NMODV, H); SEAM(17); }
    if (IN(18)) { GEMM(H, WDQ, 512, D, EpiLatent, CQG, args.in[I_QLG], SSQQ, nullptr, nullptr, nullptr); SEAM(18); }
    if (IN(19)) { GEMM(CQG, WUQ, 3072, 512, EpiUq, QQ, SSQQ, COSM, SINM, 0.07216878364870322f * 1.4426950408889634f); SEAM(19); }
    if (IN(20)) { att::attention_phase(C, QQ, KN, KR, VV, AO); SEAM(20); }
    if (IN(21)) { GEMM(AO, WMO, D, D, EpiRes, X, X, MODL(1, 5), 1.0f); SEAM(21); }
    if (IN(22)) { norm_phase(C, X, norm_g + 5 * D, MODL(1, 6), MODL(1, 7), NMODV, H); SEAM(22); }
    if (IN(23)) { GEMM(H, WFI + 3 * WFI_ELEMS, 2 * FF, D, EpiSwiGLU, A); SEAM(23); }
    if (IN(24)) { GEMM(A, WFO + 3 * WFO_ELEMS, D, FF, EpiRes, X, X, MODL(1, 8), 0.5f); SEAM(24); }
    if (IN(25)) { final_norm_phase(C, X, args.in[I_FING]); }
#undef IN
#undef SEAM
}

extern "C" void kernel_launch(void* const* d_in, const int* in_sizes, int n_in, void* d_out, int out_size, void* d_ws, size_t ws_size, hipStream_t stream) {
    static int grid = 0;
    if (grid == 0) {
        if (n_in != 22 || in_sizes[0] != M * D || out_size != M * D || ws_size < WS_END) { fprintf(stderr, "kernel_launch: unexpected problem shape (n_in %d, in0 %d, out %d, ws %zu; need ws >= %zu)\n", n_in, n_in > 0 ? in_sizes[0] : -1, out_size, ws_size, (size_t)WS_END); grid = -1; return; }
        int dev = 0, cus = 0, per_cu = 0;
        if (hipGetDevice(&dev) != hipSuccess || hipDeviceGetAttribute(&cus, hipDeviceAttributeMultiprocessorCount, dev) != hipSuccess) { grid = -1; return; }
        if (hipFuncSetAttribute((const void*)mk_fwd, hipFuncAttributeMaxDynamicSharedMemorySize, LDS_BYTES) != hipSuccess) { fprintf(stderr, "kernel_launch: hipFuncSetAttribute failed\n"); grid = -1; return; }
        if (hipOccupancyMaxActiveBlocksPerMultiprocessor(&per_cu, (const void*)mk_fwd, 512, LDS_BYTES) != hipSuccess || per_cu < 1)
            fprintf(stderr, "kernel_launch: note: occupancy query reports %d workgroups per CU\n", per_cu);
        (void)hipGetLastError();
        grid = cus;
    }
    if (grid < 0) return;
    if (hipMemsetAsync((char*)d_ws + WS_CTL, 0, CTL_ZERO_BYTES, stream) != hipSuccess) return;
    Args a{};
    for (int i = 0; i < 22; ++i) a.in[i] = (const float*)d_in[i];
    a.out = (float*)d_out; a.ws = (unsigned char*)d_ws;
#if MK_PER_PHASE
    for (int p = 0; p < N_PHASES; ++p) { a.ph_lo = p; a.ph_hi = p + 1; hipLaunchKernelGGL(mk_fwd, dim3(grid), dim3(512), LDS_BYTES, stream, a); }
#else
    a.ph_lo = 0; a.ph_hi = N_PHASES;
    hipLaunchKernelGGL(mk_fwd, dim3(grid), dim3(512), LDS_BYTES, stream, a);
#endif
    const hipError_t le = hipPeekAtLastError();
    if (le != hipSuccess) fprintf(stderr, "kernel_launch: launch failed: %s\n", hipGetErrorName(le));
}
```

```cpp
#include <hip/hip_runtime.h>
#include <cstdio>
#include <cstdint>

#ifndef MK_PER_PHASE
#define MK_PER_PHASE 0
#endif

#define MK_KPROBE_BLK 0
#ifndef MK_DOUBLE
#define MK_DOUBLE -1
#endif
#define GAS __attribute__((address_space(1)))
#define LAS __attribute__((address_space(3)))
typedef unsigned short bf16;
typedef short bf16x8 __attribute__((ext_vector_type(8)));
typedef short s16x4 __attribute__((ext_vector_type(4)));
typedef short v4i16_t __attribute__((ext_vector_type(4)));
typedef float f32x2 __attribute__((ext_vector_type(2)));
typedef float f32x4 __attribute__((ext_vector_type(4)));
typedef float f32x16 __attribute__((ext_vector_type(16)));
typedef unsigned u32x2 __attribute__((ext_vector_type(2)));
typedef unsigned u32x4 __attribute__((ext_vector_type(4)));
typedef __bf16 bf16x2_t __attribute__((ext_vector_type(2)));

constexpr int BATCH = 4, SEQ = 4096, M = BATCH * SEQ, D = 2048, FF = 5632, NMODV = 9 * D;
constexpr int RIN = 12288;
constexpr int MH = 16, QRANK = 512, KVRANK = 512;
constexpr float EPS = 1e-6f;
constexpr int MODS_TOTAL = 8 * NMODV + 4 * 2 * D;
constexpr int MODS_KV = 8 * NMODV;
constexpr int NCOLS_MODS = 2 * NMODV + 2 * D;

constexpr size_t MiB = 1u << 20;
constexpr size_t WS_CTL = 0, CTL_ZERO_BYTES = 1 * MiB;
constexpr size_t WS_MODSP = 1 * MiB, WS_MODS = 6 * MiB;
constexpr size_t WS_COSR = 7 * MiB, WS_SINR = 15 * MiB, WS_COSM = 23 * MiB, WS_SINM = 25 * MiB;
constexpr size_t WS_RSTAT = 27 * MiB, WS_SSQKV = 35 * MiB, WS_SSQQ = 35 * MiB + 512 * 1024;
constexpr size_t WS_WFI = 36 * MiB, WS_WFO = 212 * MiB, WS_WRI = 300 * MiB, WS_WRO = 348 * MiB, WS_WDKV = 364 * MiB, WS_WUKV = 367 * MiB,
                 WS_WDQ = 371 * MiB, WS_WUQ = 373 * MiB, WS_WMO = 376 * MiB;
constexpr size_t WS_H = 384 * MiB, WS_HK = 448 * MiB;
constexpr size_t WS_RA = 512 * MiB;
constexpr size_t WS_A = WS_RA, WS_RQ = WS_RA, WS_RK = WS_RA + 64 * MiB, WS_QQ = WS_RA, WS_AO = WS_RA + 96 * MiB;
constexpr size_t WS_RB = 688 * MiB;
constexpr size_t WS_RV = WS_RB, WS_RG = WS_RB + 128 * MiB, WS_RO = WS_RB + 256 * MiB;
constexpr size_t WS_CKVG = WS_RB, WS_CQG = WS_RB + 16 * MiB, WS_KR = WS_RB + 32 * MiB, WS_KN = WS_RB + 36 * MiB, WS_VV = WS_RB + 100 * MiB;
constexpr size_t WS_END = 1072 * MiB;
constexpr size_t WFI_ELEMS = (size_t)2 * FF * D, WFO_ELEMS = (size_t)D * FF;
constexpr int CW_TMO = 0, CW_BAR = 4096;

constexpr int RING_BYTES = 143360, LDSCTL_OFF = RING_BYTES, MISC_OFF = LDSCTL_OFF + 320, LDS_BYTES = 147456;

#define LDS_WAIT() asm volatile("s_waitcnt lgkmcnt(0)" ::: "memory")
#define VM_WAIT() asm volatile("s_waitcnt vmcnt(0)" ::: "memory")
__device__ __forceinline__ unsigned f2bf(float f) { unsigned u = __builtin_bit_cast(unsigned, f); return (u + 0x7fffu + ((u >> 16) & 1u)) >> 16; }
__device__ __forceinline__ unsigned pk2(float lo, float hi) { f32x2 v = {lo, hi}; bf16x2_t b = __builtin_convertvector(v, bf16x2_t); return __builtin_bit_cast(unsigned, b); }
__device__ __forceinline__ float bf_lo(unsigned w) { return __builtin_bit_cast(float, w << 16); }
__device__ __forceinline__ float bf_hi(unsigned w) { return __builtin_bit_cast(float, w & 0xffff0000u); }
__device__ __forceinline__ float silu_f(float x) { return x * __builtin_amdgcn_rcpf(1.0f + __builtin_amdgcn_exp2f(-1.4426950408889634f * x)); }
__device__ __forceinline__ float wave_sum(float v) {
#pragma unroll
    for (int o = 1; o < 64; o <<= 1) v += __shfl_xor(v, o);
    return v;
}

namespace pg8 {
typedef unsigned short bf16_t;
constexpr int BM = 256, BK = 64, HALF = 128, HTB = HALF * BK * 2, STAGE_BYTES = 8 * HTB, NXCD = 8, WGM = 8;
__host__ __device__ __forceinline__ int lds_byte(int r, int c) { const int st = (r >> 4) * 2 + (c >> 5), rr = r & 15, cc = c & 31, ob = rr * 64 + cc * 2; return st * 1024 + (ob ^ (((ob >> 9) & 1) << 5)); }
__host__ __device__ __forceinline__ void stage_rc(int b, int& R, int& C) { const int st = b / 1024, sb = b % 1024, swz = sb ^ (((sb >> 9) & 1) << 5); R = (st >> 1) * 16 + swz / 64; C = (st & 1) * 32 + (swz % 64) / 2; }
__host__ __device__ __forceinline__ int perm32(int rho) { const int n = rho >> 4, i = rho & 15; return 8 * (i >> 2) + 4 * n + (i & 3); }
struct Unit { int pm, pn; };
struct Gemm { const bf16_t* A; const bf16_t* Bt; int M, N, K; };
struct StaticOrder {
    int nM, nN, nwg, G, c;
    __host__ __device__ void init(int M_, int N_, int G_, int c_) { nM = M_ / BM; nN = N_ / BM; nwg = nM * nN; G = G_; c = c_; }
    __host__ __device__ __forceinline__ bool next(int i, Unit& u) const {
        const long L = (long)i * G + c; if (L >= nwg) return false;
        int wgid = (int)L; { const int q = nwg / NXCD, r = nwg % NXCD, xcd = wgid % NXCD, off = wgid / NXCD; wgid = (xcd < r ? xcd * (q + 1) : r * (q + 1) + (xcd - r) * q) + off; }
        const int nig = WGM * nN, gid = wgid / nig, fm = gid * WGM, gsz = (nM - fm) < WGM ? (nM - fm) : WGM;
        u.pm = fm + ((wgid % nig) % gsz); u.pn = (wgid % nig) / gsz; return true;
    }
    __device__ __forceinline__ void a_ready(const Unit&) const {}
    __device__ __forceinline__ void done(const Unit&) const {}
};
struct PanelOrder {
    int nM, nN, G, c;
    __host__ __device__ void init(int M_, int N_, int G_, int c_) { nM = M_ / BM; nN = N_ / BM; G = G_; c = c_; }
    __host__ __device__ __forceinline__ bool next(int i, Unit& u) const {
        const int x = c & 7, j = c >> 3, ppr = G >> 3;
        const int pm = i * ppr + x * (ppr >> 3) + (j >> 3);
        if (pm >= nM) return false;
        u.pm = pm; u.pn = j & 7; return true;
    }
    __device__ __forceinline__ void a_ready(const Unit&) const {}
    __device__ __forceinline__ void done(const Unit&) const {}
};
template <class Epi, class Sched>
__device__ __forceinline__ void gemm_phase(LAS unsigned char* lds, const Gemm g, const Sched& S, const Epi& E) {
    const int tid = threadIdx.x, wid = __builtin_amdgcn_readfirstlane(tid >> 6), lane = tid & 63, wr = wid >> 2, wc = wid & 3, fr = lane & 15, fq = lane >> 4;
    const int K = g.K, nt = K / BK;
    unsigned voffA[2], voffB[2];
#pragma unroll
    for (int i = 0; i < 2; ++i) { int R, C; stage_rc(tid * 16 + i * 8192, R, C); const int Rb = Epi::PERM ? ((R & ~31) + perm32(R & 31)) : R;
        voffA[i] = (unsigned)(R * K + C) * 2u; voffB[i] = (unsigned)(Rb * K + C) * 2u; }
    const size_t kstep = (size_t)(BK * 2);
    const size_t hstep = (size_t)HALF * K * 2;
    const size_t tstep = 2 * hstep;
    const unsigned ldsw = (unsigned)wid * 1024u;
    const int aoff = lds_byte(wr * 64 + fr, fq * 8), boff = lds_byte(wc * 32 + fr, fq * 8);
#define PG8_SA(b, h) (((b) * 2 + (h)) * HTB)
#define PG8_SB(b, h) ((4 + (b) * 2 + (h)) * HTB)
#define PG8_STAGE(bufoff, gbase, voff) do { _Pragma("unroll") for (int _i = 0; _i < 2; ++_i) \
        __builtin_amdgcn_global_load_lds((const unsigned*)((const char*)(gbase) + (voff)[_i]), (LAS unsigned*)(lds + (bufoff) + ldsw + _i * 8192), 16, 0, 0); } while (0)
#define PG8_LDA(dst, b, h) do { _Pragma("unroll") for (int m = 0; m < 4; ++m) _Pragma("unroll") for (int k = 0; k < 2; ++k) dst[m][k] = *(const LAS bf16x8*)(lds + PG8_SA(b, h) + aoff + m * 2048 + k * 1024); } while (0)
#define PG8_LDB(dst, b, h) do { _Pragma("unroll") for (int n = 0; n < 2; ++n) _Pragma("unroll") for (int k = 0; k < 2; ++k) dst[n][k] = *(const LAS bf16x8*)(lds + PG8_SB(b, h) + boff + n * 2048 + k * 1024); } while (0)
#define PG8_MMA(ai, bj, At, Bt) do { __builtin_amdgcn_s_setprio(1); _Pragma("unroll") for (int m = 0; m < 4; ++m) _Pragma("unroll") for (int n = 0; n < 2; ++n) _Pragma("unroll") for (int k = 0; k < 2; ++k) \
        acc[ai][bj][m][n] = __builtin_amdgcn_mfma_f32_16x16x32_bf16(Bt[n][k], At[m][k], acc[ai][bj][m][n], 0, 0, 0); __builtin_amdgcn_s_setprio(0); } while (0)
#define PG8_WAIT_V(n) asm volatile("s_waitcnt vmcnt(" #n ")" ::: "memory")
#define PG8_WAIT_L(n) asm volatile("s_waitcnt lgkmcnt(" #n ")" ::: "memory")
#define PG8_BAR __builtin_amdgcn_s_barrier()
#define PG8_SCHED __builtin_amdgcn_sched_barrier(0)
    Unit cur, nxt; int ui = 0;
    if (!S.next(0, cur)) return;
    f32x4 acc[2][2][4][2];
#pragma unroll
    for (int a = 0; a < 2; ++a)
#pragma unroll
        for (int b = 0; b < 2; ++b)
#pragma unroll
            for (int m = 0; m < 4; ++m)
#pragma unroll
                for (int n = 0; n < 2; ++n) acc[a][b][m][n] = (f32x4){0.f, 0.f, 0.f, 0.f};
    bf16x8 At[4][2], B0[2][2], B1[2][2];
    const char* cA = (const char*)g.A + (size_t)cur.pm * tstep; const char* cB = (const char*)g.Bt + (size_t)cur.pn * tstep;
    S.a_ready(cur);
    PG8_STAGE(PG8_SB(0, 0), cB, voffB); PG8_STAGE(PG8_SB(0, 1), cB + hstep, voffB); PG8_STAGE(PG8_SA(0, 0), cA, voffA); PG8_STAGE(PG8_SA(0, 1), cA + hstep, voffA);
    if (wr == 1) PG8_BAR;
    PG8_WAIT_V(2); PG8_BAR;
    PG8_STAGE(PG8_SB(1, 0), cB + kstep, voffB); PG8_STAGE(PG8_SA(1, 0), cA + kstep, voffA); PG8_STAGE(PG8_SB(1, 1), cB + hstep + kstep, voffB);
    PG8_WAIT_V(6); PG8_BAR;
    for (;;) {
        const bool has_next = S.next(ui + 1, nxt);
        const char* nA = has_next ? (const char*)g.A + (size_t)nxt.pm * tstep : cA; const char* nB = has_next ? (const char*)g.Bt + (size_t)nxt.pn * tstep : cB;
        for (int t = 0; t < nt; t += 2) {
            const bool last = (t == nt - 2);
            const char* a1 = cA + (size_t)(t + 1) * kstep;
            const char* a2 = last ? nA : cA + (size_t)(t + 2) * kstep; const char* b2 = last ? nB : cB + (size_t)(t + 2) * kstep;
            const char* a3 = a2 + kstep; const char* b3 = b2 + kstep;
            if (last && has_next) S.a_ready(nxt);
            PG8_LDB(B0, 0, 0); PG8_LDB(B1, 0, 1); PG8_SCHED; PG8_LDA(At, 0, 0); PG8_STAGE(PG8_SA(1, 1), a1 + hstep, voffA);
            PG8_WAIT_V(8); PG8_WAIT_L(0); PG8_BAR; PG8_MMA(0, 0, At, B0); PG8_MMA(0, 1, At, B1); PG8_BAR; PG8_SCHED;
            PG8_LDA(At, 0, 1); PG8_STAGE(PG8_SB(0, 0), b2, voffB); PG8_STAGE(PG8_SB(0, 1), b2 + hstep, voffB); PG8_STAGE(PG8_SA(0, 0), a2, voffA);
            PG8_WAIT_V(8); PG8_WAIT_L(0); PG8_BAR; PG8_MMA(1, 0, At, B0); PG8_MMA(1, 1, At, B1); PG8_BAR; PG8_SCHED;
            PG8_LDB(B0, 1, 0); PG8_LDB(B1, 1, 1); PG8_SCHED; PG8_LDA(At, 1, 0); PG8_STAGE(PG8_SA(0, 1), a2 + hstep, voffA);
            PG8_WAIT_V(8); PG8_WAIT_L(0); PG8_BAR; PG8_MMA(0, 0, At, B0); PG8_MMA(0, 1, At, B1); PG8_BAR; PG8_SCHED;
            PG8_LDA(At, 1, 1); PG8_STAGE(PG8_SB(1, 0), b3, voffB); PG8_STAGE(PG8_SB(1, 1), b3 + hstep, voffB); PG8_STAGE(PG8_SA(1, 0), a3, voffA);
            PG8_WAIT_V(8); PG8_WAIT_L(0); PG8_BAR; PG8_MMA(1, 0, At, B0); PG8_MMA(1, 1, At, B1); PG8_BAR; PG8_SCHED;
        }
        if (wr == 0) PG8_BAR;
        E(acc, cur, wr, wc, fr, fq); S.done(cur);
        if (!has_next) break;
#pragma unroll
        for (int a = 0; a < 2; ++a)
#pragma unroll
            for (int b = 0; b < 2; ++b)
#pragma unroll
                for (int m = 0; m < 4; ++m)
#pragma unroll
                    for (int n = 0; n < 2; ++n) acc[a][b][m][n] = (f32x4){0.f, 0.f, 0.f, 0.f};
        cur = nxt; cA = nA; cB = nB; ++ui;
        if (wr == 1) PG8_BAR;
    }
    PG8_WAIT_V(0);
    PG8_BAR;
#undef PG8_SA
#undef PG8_SB
#undef PG8_STAGE
#undef PG8_LDA
#undef PG8_LDB
#undef PG8_MMA
#undef PG8_WAIT_V
#undef PG8_WAIT_L
#undef PG8_BAR
#undef PG8_SCHED
}

typedef const f32x4 (&AccRef)[2][2][4][2];
__device__ __forceinline__ u32x4 pack8(f32x4 v0, f32x4 v1) { u32x4 w; w.x = pk2(v0[0], v0[1]); w.y = pk2(v0[2], v0[3]); w.z = pk2(v1[0], v1[1]); w.w = pk2(v1[2], v1[3]); return w; }

struct EpiSwiGLU {
    static constexpr bool PERM = true; bf16_t* O;
    __device__ __forceinline__ void operator()(AccRef acc, const Unit& u, int wr, int wc, int fr, int fq) const {
        const int row0 = u.pm * BM + wr * 64 + fr, col0 = u.pn * 128 + wc * 32 + 8 * fq;
#pragma unroll
        for (int ai = 0; ai < 2; ++ai)
#pragma unroll
            for (int m = 0; m < 4; ++m) { bf16_t* rowp = O + (size_t)(row0 + ai * HALF + m * 16) * FF + col0;
                f32x4 v0, v1;
#pragma unroll
                for (int e = 0; e < 4; ++e) { v0[e] = silu_f(acc[ai][0][m][0][e]) * acc[ai][1][m][0][e]; v1[e] = silu_f(acc[ai][0][m][1][e]) * acc[ai][1][m][1][e]; }
                *(u32x4*)rowp = pack8(v0, v1); }
    }
};
struct EpiRes {
    static constexpr bool PERM = true; const float* base; float* out; const float* gate; float gmul;
    __device__ __forceinline__ void operator()(AccRef acc, const Unit& u, int wr, int wc, int fr, int fq) const {
        const int row0 = u.pm * BM + wr * 64 + fr, col0 = u.pn * BM + wc * 32 + 8 * fq;
        const float* gp = gate + (size_t)(u.pm >> 4) * NMODV + col0;
        f32x4 gv[2][2];
#pragma unroll
        for (int bj = 0; bj < 2; ++bj)
#pragma unroll
            for (int n = 0; n < 2; ++n) gv[bj][n] = *(const f32x4*)(gp + bj * HALF + n * 4) * gmul;
#pragma unroll
        for (int ai = 0; ai < 2; ++ai) {
            f32x4 bs[4][2][2];
#pragma unroll
            for (int m = 0; m < 4; ++m)
#pragma unroll
                for (int bj = 0; bj < 2; ++bj)
#pragma unroll
                    for (int n = 0; n < 2; ++n) bs[m][bj][n] = *(const f32x4*)(base + (size_t)(row0 + ai * HALF + m * 16) * D + col0 + bj * HALF + n * 4);
#pragma unroll
            for (int m = 0; m < 4; ++m)
#pragma unroll
                for (int bj = 0; bj < 2; ++bj)
#pragma unroll
                    for (int n = 0; n < 2; ++n) *(f32x4*)(out + (size_t)(row0 + ai * HALF + m * 16) * D + col0 + bj * HALF + n * 4) = bs[m][bj][n] + gv[bj][n] * acc[ai][bj][m][n];
        }
    }
};
struct EpiRet {
    static constexpr bool PERM = true; bf16_t *RQ, *RK, *RV, *RG; const float *COS, *SIN;
    __device__ __forceinline__ void operator()(AccRef acc, const Unit& u, int wr, int wc, int fr, int fq) const {
        const int row0 = u.pm * BM + wr * 64 + fr, i0 = wc * 32 + 8 * fq;
        if (u.pn < 16) {
            bf16_t* dst = (u.pn < 8 ? RQ : RK) + (u.pn & 7) * 256 + i0; const float sc = u.pn < 8 ? 0.0625f : 1.0f;
#pragma unroll
            for (int ai = 0; ai < 2; ++ai)
#pragma unroll
                for (int m = 0; m < 4; ++m) { const int r = row0 + ai * HALF + m * 16;
                    const f32x4 c0 = *(const f32x4*)(COS + (size_t)r * 128 + i0), c1 = *(const f32x4*)(COS + (size_t)r * 128 + i0 + 4);
                    const f32x4 s0 = *(const f32x4*)(SIN + (size_t)r * 128 + i0), s1 = *(const f32x4*)(SIN + (size_t)r * 128 + i0 + 4);
                    const f32x4 x10 = acc[ai][0][m][0], x11 = acc[ai][0][m][1], x20 = acc[ai][1][m][0], x21 = acc[ai][1][m][1];
                    const f32x4 o10 = (x10 * c0 - x20 * s0) * sc, o11 = (x11 * c1 - x21 * s1) * sc, o20 = (x10 * s0 + x20 * c0) * sc, o21 = (x11 * s1 + x21 * c1) * sc;
                    *(u32x4*)(dst + (size_t)r * D) = pack8(o10, o11); *(u32x4*)(dst + (size_t)r * D + 128) = pack8(o20, o21); }
        } else {
            const bool isg = u.pn >= 32; bf16_t* dst = (isg ? RG : RV) + ((u.pn - 16) & 15) * 256 + i0;
#pragma unroll
            for (int ai = 0; ai < 2; ++ai)
#pragma unroll
                for (int m = 0; m < 4; ++m) { bf16_t* rowp = dst + (size_t)(row0 + ai * HALF + m * 16) * 4096;
#pragma unroll
                    for (int bj = 0; bj < 2; ++bj) { f32x4 v0 = acc[ai][bj][m][0], v1 = acc[ai][bj][m][1];
                        if (isg) {
#pragma unroll
                            for (int e = 0; e < 4; ++e) { v0[e] = silu_f(v0[e]); v1[e] = silu_f(v1[e]); } }
                        *(u32x4*)(rowp + bj * HALF) = pack8(v0, v1); } }
        }
    }
};
struct EpiLatent {
    static constexpr bool PERM = false; bf16_t* O; const float* g; float* ssq; bf16_t* KR; const float *COS, *SIN;
    __device__ __forceinline__ void operator()(AccRef acc, const Unit& u, int wr, int wc, int fr, int fq) const {
        const int row0 = u.pm * BM + wr * 64 + fr;
        if (u.pn < 2) {
            const int col0 = u.pn * BM + wc * 32 + 4 * fq;
            f32x4 gv[2][2];
#pragma unroll
            for (int bj = 0; bj < 2; ++bj)
#pragma unroll
                for (int n = 0; n < 2; ++n) gv[bj][n] = *(const f32x4*)(g + col0 + bj * HALF + n * 16);
#pragma unroll
            for (int ai = 0; ai < 2; ++ai)
#pragma unroll
                for (int m = 0; m < 4; ++m) { const int r = row0 + ai * HALF + m * 16; float s = 0.f;
#pragma unroll
                    for (int bj = 0; bj < 2; ++bj)
#pragma unroll
                        for (int n = 0; n < 2; ++n) { const f32x4 a = acc[ai][bj][m][n]; s += (a[0] * a[0] + a[1] * a[1]) + (a[2] * a[2] + a[3] * a[3]); const f32x4 v = a * gv[bj][n];
                            u32x2 w; w.x = pk2(v[0], v[1]); w.y = pk2(v[2], v[3]); *(u32x2*)(O + (size_t)r * 512 + col0 + bj * HALF + n * 16) = w; }
                    s += __shfl_xor(s, 16); s += __shfl_xor(s, 32);
                    if (fq == 0) ssq[(size_t)r * 8 + u.pn * 4 + wc] = s; }
        } else if (wc == 0) {
#pragma unroll
            for (int ai = 0; ai < 2; ++ai)
#pragma unroll
                for (int m = 0; m < 4; ++m) { const int r = row0 + ai * HALF + m * 16;
#pragma unroll
                    for (int n = 0; n < 2; ++n) { const int i = 16 * n + 4 * fq;
                        const f32x4 c = *(const f32x4*)(COS + (size_t)r * 32 + i), s = *(const f32x4*)(SIN + (size_t)r * 32 + i);
                        const f32x4 x1 = acc[ai][0][m][n], x2 = acc[ai][1][m][n]; const f32x4 o1 = x1 * c - x2 * s, o2 = x1 * s + x2 * c;
                        u32x2 w1, w2; w1.x = pk2(o1[0], o1[1]); w1.y = pk2(o1[2], o1[3]); w2.x = pk2(o2[0], o2[1]); w2.y = pk2(o2[2], o2[3]);
                        *(u32x2*)(KR + (size_t)r * 64 + i) = w1; *(u32x2*)(KR + (size_t)r * 64 + 32 + i) = w2; } }
        }
    }
};
__device__ __forceinline__ float row_rstd8(const float* ssq, int r, float inv_n) {
    const f32x4 a = *(const f32x4*)(ssq + (size_t)r * 8), b = *(const f32x4*)(ssq + (size_t)r * 8 + 4);
    return __builtin_amdgcn_rsqf(((a[0] + a[1]) + (a[2] + a[3]) + (b[0] + b[1]) + (b[2] + b[3])) * inv_n + EPS);
}
struct EpiUkv {
    static constexpr bool PERM = true; bf16_t *KN, *VV; const float* ssq;
    __device__ __forceinline__ void operator()(AccRef acc, const Unit& u, int wr, int wc, int fr, int fq) const {
        const int row0 = u.pm * BM + wr * 64 + fr, col0 = u.pn * 128 + wc * 32 + 8 * fq;
#pragma unroll
        for (int ai = 0; ai < 2; ++ai)
#pragma unroll
            for (int m = 0; m < 4; ++m) { const int r = row0 + ai * HALF + m * 16; const float rs = row_rstd8(ssq, r, 1.0f / 512.0f);
                *(u32x4*)(KN + (size_t)r * 2048 + col0) = pack8(acc[ai][0][m][0] * rs, acc[ai][0][m][1] * rs);
                *(u32x4*)(VV + (size_t)r * 2048 + col0) = pack8(acc[ai][1][m][0] * rs, acc[ai][1][m][1] * rs); }
    }
};
struct EpiUq {
    static constexpr bool PERM = true; bf16_t* Q; const float* ssq; const float *COS, *SIN; float qscale;
    __device__ __forceinline__ void operator()(AccRef acc, const Unit& u, int wr, int wc, int fr, int fq) const {
        const int row0 = u.pm * BM + wr * 64 + fr;
        if (u.pn < 8) {
            const int col0 = wc * 32 + 8 * fq;
#pragma unroll
            for (int ai = 0; ai < 2; ++ai)
#pragma unroll
                for (int m = 0; m < 4; ++m) { const int r = row0 + ai * HALF + m * 16; const float rs = row_rstd8(ssq, r, 1.0f / 512.0f) * qscale;
#pragma unroll
                    for (int bj = 0; bj < 2; ++bj) *(u32x4*)(Q + (size_t)r * 3072 + (2 * u.pn + bj) * 192 + col0) = pack8(acc[ai][bj][m][0] * rs, acc[ai][bj][m][1] * rs); }
        } else {
            const int head = 4 * (u.pn - 8) + wc, i0 = 8 * fq;
#pragma unroll
            for (int ai = 0; ai < 2; ++ai)
#pragma unroll
                for (int m = 0; m < 4; ++m) { const int r = row0 + ai * HALF + m * 16; const float rs = row_rstd8(ssq, r, 1.0f / 512.0f) * qscale;
                    const f32x4 c0 = *(const f32x4*)(COS + (size_t)r * 32 + i0), c1 = *(const f32x4*)(COS + (size_t)r * 32 + i0 + 4);
                    const f32x4 s0 = *(const f32x4*)(SIN + (size_t)r * 32 + i0), s1 = *(const f32x4*)(SIN + (size_t)r * 32 + i0 + 4);
                    const f32x4 x10 = acc[ai][0][m][0], x11 = acc[ai][0][m][1], x20 = acc[ai][1][m][0], x21 = acc[ai][1][m][1];
                    const f32x4 o10 = (x10 * c0 - x20 * s0) * rs, o11 = (x11 * c1 - x21 * s1) * rs, o20 = (x10 * s0 + x20 * c0) * rs, o21 = (x11 * s1 + x21 * c1) * rs;
                    bf16_t* qp = Q + (size_t)r * 3072 + head * 192 + 128 + i0;
                    *(u32x4*)qp = pack8(o10, o11); *(u32x4*)(qp + 32) = pack8(o20, o21); }
        }
    }
};
}

#define XB_TMO      128
#define XB_XCNT(j)  (256  + 64 * (j))
#define XB_XSUB(j)  (1280 + 64 * (j))
#define XB_XGEN(j)  (2304 + 64 * (j))
#define XB_TOP      3328
#define XB_TOPGEN   3392
#define XCD_BAR_WORDS 3456
#define XB_SPIN_CAP (1u << 20)
__device__ __forceinline__ unsigned xb_ld(unsigned* p)              { return __hip_atomic_load(p, __ATOMIC_RELAXED, __HIP_MEMORY_SCOPE_AGENT); }
__device__ __forceinline__ unsigned xb_add(unsigned* p, unsigned v) { return __hip_atomic_fetch_add(p, v, __ATOMIC_RELAXED, __HIP_MEMORY_SCOPE_AGENT); }
__device__ __forceinline__ unsigned xb_xcc_id() { return (unsigned)__builtin_amdgcn_s_getreg((3 << 11) | 20) & 0xFu; }
#define XB_SPIN(cond, bar) do { unsigned _sp = 0; while (cond) { __builtin_amdgcn_s_sleep(1); \
    if ((++_sp & 255u) == 0u) { if (xb_ld(&(bar)[XB_TMO])) break; if (_sp > XB_SPIN_CAP) { atomicAdd(&(bar)[XB_TMO], 1u); break; } } } } while (0)
struct XcdBarrier { unsigned* bar; unsigned x; volatile LAS unsigned* st; };
__device__ __forceinline__ XcdBarrier xcd_barrier_post(unsigned* bar, volatile LAS unsigned* st) {
    XcdBarrier b; b.bar = bar; b.x = xb_xcc_id(); b.st = st;
    if (threadIdx.x == 0) (void)xb_add(&bar[XB_XCNT(b.x)], 1u);
    return b;
}
__device__ __forceinline__ void xcd_barrier_complete(unsigned* bar, unsigned x, unsigned& nloc, unsigned& nx) {
    const unsigned G = gridDim.x * gridDim.y * gridDim.z;
    unsigned sum, cnt, mine, sp = 0u;
    for (;;) {
        sum = 0u; cnt = 0u; mine = 0u;
#pragma unroll
        for (unsigned j = 0; j < 16; ++j) { const unsigned c = xb_ld(&bar[XB_XCNT(j)]); sum += c; cnt += (c > 0u) ? 1u : 0u; mine = (j == x) ? c : mine; }
        if (sum == G) break;
        __builtin_amdgcn_s_sleep(1);
        if ((++sp & 255u) == 0u) { if (xb_ld(&bar[XB_TMO])) break; if (sp > XB_SPIN_CAP) { atomicAdd(&bar[XB_TMO], 1u); break; } }
    }
    nloc = mine > 0u ? mine : 1u; nx = cnt > 0u ? cnt : 1u;
}
__device__ __forceinline__ void xcd_barrier(const XcdBarrier& b) {
    asm volatile("s_waitcnt vmcnt(0)" ::: "memory");
    __syncthreads();
    if (threadIdx.x == 0) {
        unsigned* bar = b.bar;
        __builtin_amdgcn_s_waitcnt(0);
        unsigned nloc = b.st[0], nx = b.st[1];
        if (nloc == 0u) { xcd_barrier_complete(bar, b.x, nloc, nx); b.st[0] = nloc; b.st[1] = nx; }
        const unsigned old = xb_add(&bar[XB_XSUB(b.x)], 1u);
        const unsigned gen = old / nloc;
        if (old + 1u == (gen + 1u) * nloc) {
            __builtin_amdgcn_fence(__ATOMIC_RELEASE, "agent");
            asm volatile("s_waitcnt vmcnt(0)" ::: "memory");
            const unsigned og = xb_add(&bar[XB_TOP], 1u);
            const unsigned tg = og / nx;
            if (og + 1u == (tg + 1u) * nx) xb_add(&bar[XB_TOPGEN], 1u);
            else XB_SPIN(xb_ld(&bar[XB_TOPGEN]) == tg, bar);
            __builtin_amdgcn_fence(__ATOMIC_ACQUIRE, "agent");
            xb_add(&bar[XB_XGEN(b.x)], 1u);
            asm volatile("s_waitcnt vmcnt(0)" ::: "memory");
        } else {
            XB_SPIN(xb_ld(&bar[XB_XGEN(b.x)]) == gen, bar);
            __builtin_amdgcn_fence(__ATOMIC_ACQUIRE, "agent");
            asm volatile("s_waitcnt vmcnt(0)" ::: "memory");
        }
    }
    __syncthreads();
}

struct Ctx { LAS unsigned char* lds; int tid, lane, wave, vcu, G; };

__device__ __forceinline__ int mods_index(int n, int b) {
    if (n < NMODV) return b * NMODV + n;
    if (n < 2 * NMODV) return (4 + b) * NMODV + (n - NMODV);
    return MODS_KV + b * 2 * D + (n - 2 * NMODV);
}
__device__ __forceinline__ void mods_item(const Ctx& C, int item, const float* ada_w, const float* kv_ada_w, float* modsp) {
    const int cb = item % (NCOLS_MODS / 32), ks = item / (NCOLS_MODS / 32), n0 = cb * 32;
    const float* W; int ldw, col;
    if (n0 < NMODV) { W = ada_w; ldw = NMODV; col = n0; } else if (n0 < 2 * NMODV) { W = ada_w + (size_t)D * NMODV; ldw = NMODV; col = n0 - NMODV; } else { W = kv_ada_w; ldw = 2 * D; col = n0 - 2 * NMODV; }
    const int kr = C.lane >> 3, c4 = 4 * (C.lane & 7);
    const LAS float* cact = (const LAS float*)C.lds;
    f32x4 a0 = {0.f, 0.f, 0.f, 0.f}, a1 = a0, a2 = a0, a3 = a0;
    const float* wp = W + (size_t)(ks * 256 + kr) * ldw + col + c4;
#pragma unroll 8
    for (int it = 0; it < 32; ++it) { const f32x4 w = *(const f32x4*)(wp + (size_t)it * 8 * ldw); const int k = ks * 256 + it * 8 + kr;
        a0 += w * cact[k]; a1 += w * cact[2048 + k]; a2 += w * cact[4096 + k]; a3 += w * cact[6144 + k]; }
#pragma unroll
    for (int e = 0; e < 4; ++e) {
#pragma unroll
        for (int o = 8; o < 64; o <<= 1) { a0[e] += __shfl_xor(a0[e], o); a1[e] += __shfl_xor(a1[e], o); a2[e] += __shfl_xor(a2[e], o); a3[e] += __shfl_xor(a3[e], o); } }
    if (C.lane < 8) { float* o = modsp + (size_t)ks * MODS_TOTAL;
        *(f32x4*)(o + mods_index(n0 + c4, 0)) = a0; *(f32x4*)(o + mods_index(n0 + c4, 1)) = a1; *(f32x4*)(o + mods_index(n0 + c4, 2)) = a2; *(f32x4*)(o + mods_index(n0 + c4, 3)) = a3; }
}
__device__ __forceinline__ void transpose_tile(const float* W, int K, int N, bf16* WT, int k0, int n0, int drow0, LAS float* scr, int lane) {
#pragma unroll 8
    for (int i = 0; i < 32; ++i) { const int kk = 2 * i + (lane >> 5); scr[kk * 33 + (lane & 31)] = W[(size_t)(k0 + kk) * N + n0 + (lane & 31)]; }
    LDS_WAIT(); asm volatile("" ::: "memory");
    const int c = lane & 7;
#pragma unroll
    for (int j = 0; j < 4; ++j) { const int n = (lane >> 3) + 8 * j; const LAS float* s = scr + (8 * c) * 33 + n;
        u32x4 o; o.x = pk2(s[0 * 33], s[1 * 33]); o.y = pk2(s[2 * 33], s[3 * 33]); o.z = pk2(s[4 * 33], s[5 * 33]); o.w = pk2(s[6 * 33], s[7 * 33]);
        *(GAS u32x4*)(WT + (size_t)(drow0 + n) * K + k0 + 8 * c) = o; }
    LDS_WAIT(); asm volatile("" ::: "memory");
}
enum MapKind { MAP_ID = 0, MAP_FFI = 1, MAP_DKV = 2, MAP_UQ = 3 };
__device__ __forceinline__ int map_row(int kind, int n0) {
    if (kind == MAP_FFI) { const int half = n0 >= FF ? 1 : 0, j = n0 - half * FF; return 256 * (j >> 7) + 128 * half + (j & 127); }
    if (kind == MAP_DKV) { return n0 < 544 ? n0 : 640 + (n0 - 544); }
    if (kind == MAP_UQ) { const int head = n0 / 192, d = n0 % 192; if (d < 128) return (head >> 1) * 256 + (head & 1) * 128 + d;
        const int i = d - 128; return 2048 + (head >> 2) * 256 + (i >> 5) * 128 + (head & 3) * 32 + (i & 31); }
    return n0;
}
__device__ __forceinline__ void cvt_item(const float* W, int K, int N, bf16* WT, int kind, int r, LAS float* scr, int lane) {
    const int nblk = N / 32, kb = r / nblk, nb = r % nblk;
    transpose_tile(W, K, N, WT, 64 * kb, 32 * nb, map_row(kind, 32 * nb), scr, lane);
}
__device__ __forceinline__ void sincos_acc(float ang, float& c, float& s) {
    const double x = (double)ang; const double n = __builtin_rint(x * 0.63661977236758134308);
    double r = __builtin_fma(-n, 1.57079632679489655800, x); r = __builtin_fma(-n, 6.12323399573676603587e-17, r);
    const double r2 = r * r;
    double sp = 1.0 / 6227020800.0; sp = sp * r2 - 1.0 / 39916800.0; sp = sp * r2 + 1.0 / 362880.0; sp = sp * r2 - 1.0 / 5040.0; sp = sp * r2 + 1.0 / 120.0; sp = sp * r2 - 1.0 / 6.0; sp = sp * r2 + 1.0; sp *= r;
    double cp = -1.0 / 87178291200.0; cp = cp * r2 + 1.0 / 479001600.0; cp = cp * r2 - 1.0 / 3628800.0; cp = cp * r2 + 1.0 / 40320.0; cp = cp * r2 - 1.0 / 720.0; cp = cp * r2 + 1.0 / 24.0; cp = cp * r2 - 0.5; cp = cp * r2 + 1.0;
    const int q = ((int)n) & 3;
    const double cc = (q == 0) ? cp : (q == 1) ? -sp : (q == 2) ? -cp : sp;
    const double ss = (q == 0) ? sp : (q == 1) ? cp : (q == 2) ? -sp : -cp;
    c = (float)cc; s = (float)ss;
}

__device__ __forceinline__ void norm_phase(const Ctx& C, const float* X, const float* g, const float* shift, const float* scale, int bstride, bf16* H) {
    const int gw = C.vcu * 8 + C.wave, NGW = C.G * 8;
    for (int m0 = gw * 8; m0 < M; m0 += NGW * 8) {
        const int b = m0 >> 12;
        f32x4 gs[8], sh[8];
#pragma unroll
        for (int j = 0; j < 8; ++j) { const int c = 4 * C.lane + 256 * j; const f32x4 gg = *(const f32x4*)(g + c), sc = *(const f32x4*)(scale + (size_t)b * bstride + c);
            gs[j] = gg * (sc + 1.0f); sh[j] = *(const f32x4*)(shift + (size_t)b * bstride + c); }
        for (int r = 0; r < 8; ++r) {
            const GAS f32x4* xr = (const GAS f32x4*)(X + (size_t)(m0 + r) * D) + C.lane;
            f32x4 v[8]; float s = 0.f;
#pragma unroll
            for (int j = 0; j < 8; ++j) { v[j] = xr[64 * j]; s += (v[j].x * v[j].x + v[j].y * v[j].y) + (v[j].z * v[j].z + v[j].w * v[j].w); }
            const float rstd = __builtin_amdgcn_rsqf(wave_sum(s) * (1.0f / D) + EPS);
            GAS u32x2* o8 = (GAS u32x2*)(H + (size_t)(m0 + r) * D) + C.lane;
#pragma unroll
            for (int j = 0; j < 8; ++j) { const f32x4 y = v[j] * rstd * gs[j] + sh[j]; u32x2 w; w.x = pk2(y.x, y.y); w.y = pk2(y.z, y.w); o8[64 * j] = w; }
        }
    }
}
__device__ __forceinline__ void final_norm_phase(const Ctx& C, float* X, const float* g) {
    const int gw = C.vcu * 8 + C.wave, NGW = C.G * 8;
    f32x4 gs[8];
#pragma unroll
    for (int j = 0; j < 8; ++j) gs[j] = *(const f32x4*)(g + 4 * C.lane + 256 * j);
    for (int m = gw; m < M; m += NGW) {
        GAS f32x4* xr = (GAS f32x4*)(X + (size_t)m * D) + C.lane;
        f32x4 v[8]; float s = 0.f;
#pragma unroll
        for (int j = 0; j < 8; ++j) { v[j] = xr[64 * j]; s += (v[j].x * v[j].x + v[j].y * v[j].y) + (v[j].z * v[j].z + v[j].w * v[j].w); }
        const float rstd = __builtin_amdgcn_rsqf(wave_sum(s) * (1.0f / D) + EPS);
#pragma unroll
        for (int j = 0; j < 8; ++j) xr[64 * j] = v[j] * rstd * gs[j];
    }
}

namespace ret {
constexpr int PQ = 528, PV = 272;
constexpr int QI = 0, KI = 64 * PQ, ST = 2 * 64 * PQ, VI = 3 * 64 * PQ, RED = VI + 64 * PV, RET_LDS = RED + 16384;
static_assert(RET_LDS <= RING_BYTES, "retention LDS");
__device__ __forceinline__ s16x4 trd(const LAS unsigned char* p) { return __builtin_bit_cast(s16x4, __builtin_amdgcn_ds_read_tr16_b64_v4i16((LAS v4i16_t*)p)); }
__device__ __forceinline__ bf16x8 cat(s16x4 lo, s16x4 hi) { return (bf16x8){lo[0], lo[1], lo[2], lo[3], hi[0], hi[1], hi[2], hi[3]}; }
#define MFMA16(a, b, c) __builtin_amdgcn_mfma_f32_16x16x32_bf16((a), (b), (c), 0, 0, 0)

__device__ __forceinline__ void retention_phase(const Ctx& C, const bf16* RQ, const bf16* RK, const bf16* RV, bf16* RO, float* RSTAT) {
    LAS unsigned char* lds = C.lds;
    const int tid = C.tid, lane = C.lane, w = C.wave, l15 = lane & 15, quad = lane >> 4, q4 = (lane & 15) >> 2, p4 = lane & 3;
    const int ci = w & 3, rh = w >> 2;
    const LAS unsigned char* bQ  = lds + QI + (16 * ci + l15) * PQ + quad * 16;
    const LAS unsigned char* bK  = lds + KI + (32 * rh + l15) * PQ + quad * 16;
    const LAS unsigned char* bS  = lds + ST + l15 * PQ + quad * 16;
    const LAS unsigned char* bV1 = lds + VI + (32 * rh + 4 * quad + q4) * PV + p4 * 8;
    const LAS unsigned char* bK2 = lds + KI + (8 * quad + q4) * PQ + (32 * w + 4 * p4) * 2;
    const LAS unsigned char* bV2 = lds + VI + (8 * quad + q4) * PV + p4 * 8 + 128;
    LAS unsigned char* bSW = lds + ST + l15 * PQ + (32 * w + 4 * quad) * 2;
    LAS unsigned char* bR  = lds + RED + ci * 4096 + lane * 4;
    LAS unsigned char* bSt = lds + (tid >> 5) * PQ + (tid & 31) * 16;
    const int vrow = tid >> 3, vch = tid & 7;
    LAS unsigned char* bVs = lds + VI + vrow * PV + vch * 16;
    for (int unit = C.vcu; unit < 256; unit += C.G) {
        const int b = unit >> 6, h = (unit >> 3) & 7, vs = unit & 7;
        const float log2g = __builtin_log2f(1.0f - __builtin_exp2f(-5.0f - (float)h));
        const float gchunk = __builtin_exp2f(log2g * 64.0f);
        float fdec[2][4];
        const int iq = 16 * ci + l15;
#pragma unroll
        for (int jt = 0; jt < 2; ++jt)
#pragma unroll
            for (int e = 0; e < 4; ++e) { const int j = 32 * rh + 16 * jt + 4 * quad + e; const int d = (iq > j ? iq - j : j - iq) - (iq + 1); fdec[jt][e] = __builtin_exp2f(log2g * (float)d); }
        const float xi = __builtin_exp2f(log2g * (float)(iq + 1));
        const float zeta = __builtin_exp2f(log2g * (float)(63 - vrow));
        __syncthreads();
        for (int i = tid; i < 64 * PQ / 16; i += 512) *(LAS u32x4*)(lds + ST + i * 16) = (u32x4){0u, 0u, 0u, 0u};
        f32x4 st[2][4];
#pragma unroll
        for (int mt = 0; mt < 2; ++mt)
#pragma unroll
            for (int nt = 0; nt < 4; ++nt) st[mt][nt] = (f32x4){0.f, 0.f, 0.f, 0.f};
        const size_t tok0 = (size_t)b * SEQ;
        const bf16* qg = RQ + (tok0 + (tid >> 5)) * D + h * 256 + (tid & 31) * 8; const bf16* kg = RK + (tok0 + (tid >> 5)) * D + h * 256 + (tid & 31) * 8;
        const bf16* vg = RV + (tok0 + vrow) * 4096 + h * 512 + vs * 64 + vch * 8;
        u32x4 qreg[4], kreg[4], vreg;
#define RET_LOAD(c) do { const size_t t0_ = (size_t)(c) * 64; _Pragma("unroll") for (int i = 0; i < 4; ++i) { \
            qreg[i] = *(const GAS u32x4*)(qg + (t0_ + 16 * i) * D); kreg[i] = *(const GAS u32x4*)(kg + (t0_ + 16 * i) * D); } \
            vreg = *(const GAS u32x4*)(vg + t0_ * 4096); } while (0)
#define RET_STORE() do { _Pragma("unroll") for (int i = 0; i < 4; ++i) { *(LAS u32x4*)(bSt + QI + 16 * i * PQ) = qreg[i]; *(LAS u32x4*)(bSt + KI + 16 * i * PQ) = kreg[i]; } \
            *(LAS u32x4*)(bVs) = vreg; \
            u32x4 vz; vz.x = pk2(bf_lo(vreg.x) * zeta, bf_hi(vreg.x) * zeta); vz.y = pk2(bf_lo(vreg.y) * zeta, bf_hi(vreg.y) * zeta); vz.z = pk2(bf_lo(vreg.z) * zeta, bf_hi(vreg.z) * zeta); vz.w = pk2(bf_lo(vreg.w) * zeta, bf_hi(vreg.w) * zeta); \
            *(LAS u32x4*)(bVs + 128) = vz; } while (0)
        RET_LOAD(0);
        RET_STORE();
        RET_LOAD(1);
#pragma unroll 1
        for (int c = 0; c < 64; ++c) {
            __syncthreads();
            f32x4 sT[2] = {(f32x4){0.f, 0.f, 0.f, 0.f}, (f32x4){0.f, 0.f, 0.f, 0.f}};
            f32x4 acc[4];
#pragma unroll
            for (int t = 0; t < 4; ++t) acc[t] = (f32x4){0.f, 0.f, 0.f, 0.f};
#pragma unroll
            for (int s = 0; s < 8; ++s) {
                const bf16x8 qf = *(const LAS bf16x8*)(bQ + 64 * s);
#pragma unroll
                for (int jt = 0; jt < 2; ++jt) { const bf16x8 kf = *(const LAS bf16x8*)(bK + 16 * jt * PQ + 64 * s); sT[jt] = MFMA16(kf, qf, sT[jt]); }
                if ((s >> 2) == rh) {
#pragma unroll
                    for (int t = 0; t < 4; ++t) { const bf16x8 sf = *(const LAS bf16x8*)(bS + 16 * t * PQ + 64 * s); acc[t] = MFMA16(sf, qf, acc[t]); }
                }
            }
            u32x4 pw; pw.x = pk2(sT[0][0] * fdec[0][0], sT[0][1] * fdec[0][1]); pw.y = pk2(sT[0][2] * fdec[0][2], sT[0][3] * fdec[0][3]);
            pw.z = pk2(sT[1][0] * fdec[1][0], sT[1][1] * fdec[1][1]); pw.w = pk2(sT[1][2] * fdec[1][2], sT[1][3] * fdec[1][3]);
            const bf16x8 pf = __builtin_bit_cast(bf16x8, pw);
#pragma unroll
            for (int t = 0; t < 4; ++t) {
                const s16x4 lo = trd(bV1 + 32 * t), hi = trd(bV1 + 16 * PV + 32 * t);
                acc[t] = MFMA16(cat(lo, hi), pf, acc[t]);
            }
#pragma unroll
            for (int mt = 0; mt < 2; ++mt)
#pragma unroll
                for (int nt = 0; nt < 4; ++nt) st[mt][nt] *= gchunk;
#pragma unroll
            for (int ks = 0; ks < 2; ++ks) {
                bf16x8 af[2], bfv[4];
#pragma unroll
                for (int mt = 0; mt < 2; ++mt) af[mt] = cat(trd(bK2 + (32 * ks) * PQ + 32 * mt), trd(bK2 + (32 * ks + 4) * PQ + 32 * mt));
#pragma unroll
                for (int nt = 0; nt < 4; ++nt) bfv[nt] = cat(trd(bV2 + (32 * ks) * PV + 32 * nt), trd(bV2 + (32 * ks + 4) * PV + 32 * nt));
#pragma unroll
                for (int mt = 0; mt < 2; ++mt)
#pragma unroll
                    for (int nt = 0; nt < 4; ++nt) st[mt][nt] = MFMA16(af[mt], bfv[nt], st[mt][nt]);
            }
            if (rh == 1) {
#pragma unroll
                for (int t = 0; t < 4; ++t)
#pragma unroll
                    for (int e = 0; e < 4; ++e) *(LAS float*)(bR + (t * 4 + e) * 256) = acc[t][e];
            }
            __syncthreads();
            if (rh == 0) {
                float s1 = 0.f, s2 = 0.f;
                bf16* op = RO + (tok0 + (size_t)c * 64 + iq) * 4096 + h * 512 + vs * 64 + 4 * quad;
#pragma unroll
                for (int t = 0; t < 4; ++t) { f32x4 o;
#pragma unroll
                    for (int e = 0; e < 4; ++e) { o[e] = (acc[t][e] + *(const LAS float*)(bR + (t * 4 + e) * 256)) * xi; s1 += o[e]; s2 += o[e] * o[e]; }
                    u32x2 wv; wv.x = pk2(o[0], o[1]); wv.y = pk2(o[2], o[3]); *(GAS u32x2*)(op + 16 * t) = wv; }
                s1 += __shfl_xor(s1, 16); s1 += __shfl_xor(s1, 32); s2 += __shfl_xor(s2, 16); s2 += __shfl_xor(s2, 32);
                if (quad == 0) *(GAS f32x2*)(RSTAT + (((tok0 + (size_t)c * 64 + iq) * 8 + h) * 8 + vs) * 2) = (f32x2){s1, s2};
            }
#pragma unroll
            for (int mt = 0; mt < 2; ++mt)
#pragma unroll
                for (int nt = 0; nt < 4; ++nt) { u32x2 wv; wv.x = pk2(st[mt][nt][0], st[mt][nt][1]); wv.y = pk2(st[mt][nt][2], st[mt][nt][3]); *(LAS u32x2*)(bSW + 16 * nt * PQ + 32 * mt) = wv; }
            if (c + 1 < 64) { RET_STORE(); if (c + 2 < 64) RET_LOAD(c + 2); }
        }
#undef RET_LOAD
#undef RET_STORE
    }
    __syncthreads();
}
__device__ __forceinline__ void gate_phase(const Ctx& C, const bf16* RO, bf16* RG, const float* RSTAT, const float* gn_g) {
    const int gw = C.vcu * 8 + C.wave, NGW = C.G * 8;
    for (int m = gw; m < M; m += NGW) {
#pragma unroll
        for (int k = 0; k < 8; ++k) {
            const float* sp = RSTAT + ((size_t)m * 8 + k) * 16; float s1 = 0.f, s2 = 0.f;
#pragma unroll
            for (int j = 0; j < 4; ++j) { const f32x4 v = *(const f32x4*)(sp + 4 * j); s1 += v[0] + v[2]; s2 += v[1] + v[3]; }
            const float mu = s1 * (1.0f / 512.0f), var = s2 * (1.0f / 512.0f) - mu * mu, rstd = __builtin_amdgcn_rsqf(var + EPS);
            const size_t off = (size_t)m * 4096 + 8 * (C.lane + 64 * k);
            const u32x4 ov = *(const GAS u32x4*)(RO + off), gv = *(const GAS u32x4*)(RG + off);
            const f32x4 g0 = *(const f32x4*)(gn_g + 8 * (C.lane + 64 * k)), g1 = *(const f32x4*)(gn_g + 8 * (C.lane + 64 * k) + 4);
            u32x4 r;
            r.x = pk2(bf_lo(gv.x) * (bf_lo(ov.x) - mu) * rstd * g0[0], bf_hi(gv.x) * (bf_hi(ov.x) - mu) * rstd * g0[1]);
            r.y = pk2(bf_lo(gv.y) * (bf_lo(ov.y) - mu) * rstd * g0[2], bf_hi(gv.y) * (bf_hi(ov.y) - mu) * rstd * g0[3]);
            r.z = pk2(bf_lo(gv.z) * (bf_lo(ov.z) - mu) * rstd * g1[0], bf_hi(gv.z) * (bf_hi(ov.z) - mu) * rstd * g1[1]);
            r.w = pk2(bf_lo(gv.w) * (bf_lo(ov.w) - mu) * rstd * g1[2], bf_hi(gv.w) * (bf_hi(ov.w) - mu) * rstd * g1[3]);
            *(GAS u32x4*)(RG + off) = r;
        }
    }
}
}

namespace att {
constexpr int STAGE = 40960, VOFF = 24576, ATT_LDS = 3 * STAGE;
static_assert(ATT_LDS <= RING_BYTES, "attention LDS");
using ret::cat;
#define MFMA32(a, b, c) __builtin_amdgcn_mfma_f32_32x32x16_bf16((a), (b), (c), 0, 0, 0)
#define ATT_BAR() do { __builtin_amdgcn_s_barrier(); asm volatile("" ::: "memory"); } while (0)

__device__ __forceinline__ void attention_phase(const Ctx& C, const bf16* QQ, const bf16* KN, const bf16* KR, const bf16* VV, bf16* AO) {
    LAS unsigned char* lds = C.lds;
    const int lane = C.lane, w = C.wave, r32 = lane & 31, hi = lane >> 5, grp = w >> 2;
    const unsigned lnoff = (unsigned)r32 * 2048u + 8u * hi, lroff = (unsigned)r32 * 64u + 8u * hi;
    const unsigned lvoff = (unsigned)(8 * (lane >> 5) + 4 * ((lane >> 4) & 1) + ((lane >> 1) & 3)) * 2048u + (unsigned)(2 * ((lane >> 3) & 1) + (lane & 1)) * 8u;
    for (int pair = C.vcu; pair < 512; pair += C.G) {
#pragma unroll 1
        for (int half = 0; half < 2; ++half) {
            const int bh = pair >> 3, pr = pair & 7, qb = half ? 15 - pr : pr, b = bh >> 4, h = bh & 15;
            const size_t tok0 = (size_t)b * SEQ;
            const int NT = 4 * qb + 4, myc = 4 * qb + (w >> 1);
            asm volatile("s_waitcnt vmcnt(0)" ::: "memory"); ATT_BAR();
            bf16x8 qf[12];
            { const bf16* qp = QQ + (tok0 + (size_t)qb * 256 + w * 32 + r32) * 3072 + h * 192 + 8 * hi;
#pragma unroll
              for (int s = 0; s < 12; ++s) qf[s] = *(const GAS bf16x8*)(qp + 16 * s); }
            const bf16* knb = KN + tok0 * 2048 + h * 128; const bf16* krb = KR + tok0 * 64; const bf16* vvb = VV + tok0 * 2048 + h * 128;
#define ATT_DMA(t, stg) do { LAS unsigned char* sb_ = lds + (stg) * STAGE; \
                _Pragma("unroll") for (int i = 0; i < 3; ++i) { const int j = 3 * w + i, kk = j / 12, s = j % 12; \
                    const bf16* src = s < 8 ? knb + ((size_t)(t) * 64 + 32 * kk) * 2048 + 16 * s + lnoff : krb + ((size_t)(t) * 64 + 32 * kk) * 64 + 16 * (s - 8) + lroff; \
                    __builtin_amdgcn_global_load_lds((const unsigned*)src, (LAS unsigned*)(sb_ + j * 1024), 16, 0, 0); } \
                _Pragma("unroll") for (int i = 0; i < 2; ++i) { const int j = 2 * w + i, s2 = j >> 2, c = j & 3; \
                    const bf16* src = vvb + ((size_t)(t) * 64 + 16 * s2) * 2048 + 32 * c + lvoff; \
                    __builtin_amdgcn_global_load_lds((const unsigned*)src, (LAS unsigned*)(sb_ + VOFF + j * 1024), 16, 0, 0); } } while (0)
            ATT_DMA(0, 0); ATT_DMA(1, 1);
            f32x16 o[4];
#pragma unroll
            for (int c = 0; c < 4; ++c)
#pragma unroll
                for (int r = 0; r < 16; ++r) o[c][r] = 0.f;
            float mrun = 0.f, lsum = 0.f;
            f32x16 s0, s1;
            if (grp == 1) { asm volatile("s_waitcnt vmcnt(5)" ::: "memory"); ATT_BAR(); }
#define ATT_STEP(t, CUR, NX) do { \
                if (grp == 0) { if ((t) + 1 < NT) asm volatile("s_waitcnt vmcnt(5)" ::: "memory"); else asm volatile("s_waitcnt vmcnt(0)" ::: "memory"); } \
                ATT_BAR(); \
                if ((t) <= myc) { \
                    const unsigned ka = (unsigned)(size_t)(lds + (CUR) * STAGE + lane * 16); \
                    u32x4 k0b[2], k1b[2]; \
                    asm volatile("ds_read_b128 %0, %2 offset:%c3\n\tds_read_b128 %1, %2 offset:%c4" : "=&v"(k0b[0]), "=&v"(k1b[0]) : "v"(ka), "i"(0), "i"(12 * 1024) : "memory"); \
                    { const float nm_ = -mrun; _Pragma("unroll") for (int r = 0; r < 16; ++r) { s0[r] = nm_; s1[r] = nm_; } } \
                    _Pragma("unroll") for (int s = 0; s < 12; ++s) { \
                        if (s + 1 < 12) { asm volatile("ds_read_b128 %0, %2 offset:%c3\n\tds_read_b128 %1, %2 offset:%c4" : "=&v"(k0b[(s + 1) & 1]), "=&v"(k1b[(s + 1) & 1]) : "v"(ka), "i"((s + 1) * 1024), "i"((13 + s) * 1024) : "memory"); \
                                          asm volatile("s_waitcnt lgkmcnt(2)" ::: "memory"); } \
                        else asm volatile("s_waitcnt lgkmcnt(0)" ::: "memory"); \
                        __builtin_amdgcn_sched_barrier(0); \
                        s0 = MFMA32(__builtin_bit_cast(bf16x8, k0b[s & 1]), qf[s], s0); s1 = MFMA32(__builtin_bit_cast(bf16x8, k1b[s & 1]), qf[s], s1); \
                        __builtin_amdgcn_sched_barrier(0); } \
                } \
                if (grp == 1) asm volatile("s_waitcnt vmcnt(0)" ::: "memory"); \
                ATT_BAR(); \
                if ((t) + 2 < NT) { ATT_DMA((t) + 2, NX); } \
                if ((t) <= myc) { \
                    float mx = __builtin_fmaxf(s0[0], s1[0]); \
                    _Pragma("unroll") for (int r = 1; r < 16; ++r) mx = __builtin_fmaxf(mx, __builtin_fmaxf(s0[r], s1[r])); \
                    mx = __builtin_fmaxf(mx, __shfl_xor(mx, 32)); \
                    if ((t) == 0 || __any(mx > 8.0f)) {                 \
                        const float d = (t) == 0 ? mx : __builtin_fmaxf(mx, 0.f), alpha = __builtin_amdgcn_exp2f(-d); mrun += d; lsum *= alpha; \
                        _Pragma("unroll") for (int r = 0; r < 16; ++r) { s0[r] -= d; s1[r] -= d; } \
                        _Pragma("unroll") for (int c = 0; c < 4; ++c) _Pragma("unroll") for (int r = 0; r < 16; ++r) o[c][r] *= alpha; \
                    } \
                    float ps = 0.f; \
                    _Pragma("unroll") for (int r = 0; r < 16; ++r) { s0[r] = __builtin_amdgcn_exp2f(s0[r]); s1[r] = __builtin_amdgcn_exp2f(s1[r]); ps += s0[r] + s1[r]; } \
                    lsum += ps; \
                    bf16x8 pf[4]; \
                    { u32x4 a; a.x = pk2(s0[0], s0[1]); a.y = pk2(s0[2], s0[3]); a.z = pk2(s0[4], s0[5]); a.w = pk2(s0[6], s0[7]); pf[0] = __builtin_bit_cast(bf16x8, a); \
                      a.x = pk2(s0[8], s0[9]); a.y = pk2(s0[10], s0[11]); a.z = pk2(s0[12], s0[13]); a.w = pk2(s0[14], s0[15]); pf[1] = __builtin_bit_cast(bf16x8, a); \
                      a.x = pk2(s1[0], s1[1]); a.y = pk2(s1[2], s1[3]); a.z = pk2(s1[4], s1[5]); a.w = pk2(s1[6], s1[7]); pf[2] = __builtin_bit_cast(bf16x8, a); \
                      a.x = pk2(s1[8], s1[9]); a.y = pk2(s1[10], s1[11]); a.z = pk2(s1[12], s1[13]); a.w = pk2(s1[14], s1[15]); pf[3] = __builtin_bit_cast(bf16x8, a); } \
                    const unsigned vb = (unsigned)(size_t)(lds + (CUR) * STAGE + VOFF + lane * 8); \
                    s16x4 vl[2], vh[2]; \
                    asm volatile("ds_read_b64_tr_b16 %0, %2 offset:%c3\n\tds_read_b64_tr_b16 %1, %2 offset:%c4" : "=&v"(vl[0]), "=&v"(vh[0]) : "v"(vb), "i"(0), "i"(512) : "memory"); \
                    _Pragma("unroll") for (int ix = 0; ix < 16; ++ix) { \
                        if (ix + 1 < 16) { asm volatile("ds_read_b64_tr_b16 %0, %2 offset:%c3\n\tds_read_b64_tr_b16 %1, %2 offset:%c4" : "=&v"(vl[(ix + 1) & 1]), "=&v"(vh[(ix + 1) & 1]) : "v"(vb), "i"((ix + 1) * 1024), "i"((ix + 1) * 1024 + 512) : "memory"); \
                                           asm volatile("s_waitcnt lgkmcnt(2)" ::: "memory"); } \
                        else asm volatile("s_waitcnt lgkmcnt(0)" ::: "memory"); \
                        __builtin_amdgcn_sched_barrier(0); \
                        o[ix & 3] = MFMA32(cat(vl[ix & 1], vh[ix & 1]), pf[ix >> 2], o[ix & 3]); \
                        __builtin_amdgcn_sched_barrier(0); } \
                } } while (0)
#pragma unroll 1
            for (int t = 0; t < NT; t += 3) {
                ATT_STEP(t, 0, 2);
                if (t + 1 < NT) ATT_STEP(t + 1, 1, 0);
                if (t + 2 < NT) ATT_STEP(t + 2, 2, 1);
            }
#undef ATT_STEP
            if (grp == 0) ATT_BAR();
            const float linv = 1.0f / (lsum + __shfl_xor(lsum, 32));
            bf16* op = AO + (tok0 + (size_t)qb * 256 + w * 32 + r32) * 2048 + h * 128 + 4 * hi;
#pragma unroll
            for (int c = 0; c < 4; ++c)
#pragma unroll
                for (int g4 = 0; g4 < 4; ++g4) { u32x2 wv; wv.x = pk2(o[c][4 * g4] * linv, o[c][4 * g4 + 1] * linv); wv.y = pk2(o[c][4 * g4 + 2] * linv, o[c][4 * g4 + 3] * linv);
                    *(GAS u32x2*)(op + 32 * c + 8 * g4) = wv; }
#undef ATT_DMA
        }
    }
    asm volatile("s_waitcnt vmcnt(0)" ::: "memory");
    __syncthreads();
}
}

struct Args { const float* in[22]; float* out; unsigned char* ws; int ph_lo, ph_hi; };
enum { I_X = 0, I_C, I_POS, I_ADAW, I_ADAB, I_NORMG, I_FFI, I_FFO, I_RWI, I_RGN, I_RWO, I_KVAW, I_KVAB, I_KVNG, I_WDKV, I_KVLG, I_WUKV, I_WDQ, I_QLG, I_WUQ, I_WMO, I_FING };
constexpr int N_PHASES = 28;
__device__ __forceinline__ void prologue_phase(const Ctx& C, const Args& args, float* MODSP, bf16* WFI, bf16* WFO, bf16* WRI, bf16* WRO, bf16* WDKV, bf16* WUKV, bf16* WDQ, bf16* WUQ, bf16* WMO,
                                               float* COSR, float* SINR, float* COSM, float* SINM) {
    __syncthreads();
        { const float* c = args.in[I_C]; LAS float* cact = (LAS float*)C.lds; for (int i = C.tid; i < 4 * D; i += 512) cact[i] = silu_f(c[i]); }
        __syncthreads();
        const int gw = C.vcu * 8 + C.wave, NGW = C.G * 8;
        constexpr int N_MODS_ITEMS = (NCOLS_MODS / 32) * 8;
        for (int it = gw; it < N_MODS_ITEMS; it += NGW) mods_item(C, it, args.in[I_ADAW], args.in[I_KVAW], MODSP);
        LAS float* scr = (LAS float*)(C.lds + 32768 + C.wave * 8448);
        constexpr int I_FI = (D / 64) * (2 * FF / 32), I_FO = (FF / 64) * (D / 32), I_RI = (D / 64) * (RIN / 32), I_RO = (4096 / 64) * (D / 32), I_DKV = (D / 64) * (576 / 32),
                      I_UKV = (512 / 64) * (4096 / 32), I_DQ = (D / 64) * (512 / 32), I_UQ = (512 / 64) * (3072 / 32), I_MO = (D / 64) * (D / 32);
        constexpr int NITEMS = 4 * I_FI + 4 * I_FO + I_RI + I_RO + I_DKV + I_UKV + I_DQ + I_UQ + I_MO;
        for (int it = gw; it < NITEMS; it += NGW) {
            int r = it;
            if (r < 4 * I_FI) { const int q = r / I_FI; cvt_item(args.in[I_FFI] + (size_t)q * D * 2 * FF, D, 2 * FF, WFI + (size_t)q * WFI_ELEMS, MAP_FFI, r % I_FI, scr, C.lane); continue; } r -= 4 * I_FI;
            if (r < 4 * I_FO) { const int q = r / I_FO; cvt_item(args.in[I_FFO] + (size_t)q * FF * D, FF, D, WFO + (size_t)q * WFO_ELEMS, MAP_ID, r % I_FO, scr, C.lane); continue; } r -= 4 * I_FO;
            if (r < I_RI) { cvt_item(args.in[I_RWI], D, RIN, WRI, MAP_ID, r, scr, C.lane); continue; } r -= I_RI;
            if (r < I_RO) { cvt_item(args.in[I_RWO], 4096, D, WRO, MAP_ID, r, scr, C.lane); continue; } r -= I_RO;
            if (r < I_DKV) { cvt_item(args.in[I_WDKV], D, 576, WDKV, MAP_DKV, r, scr, C.lane); continue; } r -= I_DKV;
            if (r < I_UKV) { cvt_item(args.in[I_WUKV], 512, 4096, WUKV, MAP_ID, r, scr, C.lane); continue; } r -= I_UKV;
            if (r < I_DQ) { cvt_item(args.in[I_WDQ], D, 512, WDQ, MAP_ID, r, scr, C.lane); continue; } r -= I_DQ;
            if (r < I_UQ) { cvt_item(args.in[I_WUQ], 512, 3072, WUQ, MAP_UQ, r, scr, C.lane); continue; } r -= I_UQ;
            cvt_item(args.in[I_WMO], D, D, WMO, MAP_ID, r, scr, C.lane);
        }
        { const int gt = C.vcu * 512 + C.tid, NGT = C.G * 512;
          for (int i = gt; i < 192 * 256; i += NGT) { const int rr = i >> 8, c16 = i & 255; const int row = rr < 96 ? 544 + rr : 672 + (rr - 96); *(GAS u32x4*)(WDKV + (size_t)row * D + c16 * 8) = (u32x4){0u, 0u, 0u, 0u}; }
          const int* pos = (const int*)args.in[I_POS];
          for (int i = gt; i < M * 128; i += NGT) { const int m = i >> 7, j = i & 127; const float inv = (float)exp2(-(double)j * (13.287712379549449 / 128.0)); float cc, ss; sincos_acc((float)pos[m] * inv, cc, ss); COSR[i] = cc; SINR[i] = ss; }
          for (int i = gt; i < M * 32; i += NGT) { const int m = i >> 5, j = i & 31; const float inv = (float)exp2(-(double)j * (13.287712379549449 / 32.0)); float cc, ss; sincos_acc((float)pos[m] * inv, cc, ss); COSM[i] = cc; SINM[i] = ss; }
        }
}

__global__ void __launch_bounds__(512, 2) mk_fwd(Args args) {
    extern __shared__ __attribute__((aligned(16))) unsigned char lds_raw[];
    Ctx C;
    C.lds = (LAS unsigned char*)lds_raw;
    C.tid = threadIdx.x; C.lane = C.tid & 63; C.wave = __builtin_amdgcn_readfirstlane(C.tid >> 6);
    C.G = gridDim.x; { const int bx = blockIdx.x; C.vcu = (C.G % 8 == 0) ? (bx % 8) * (C.G / 8) + bx / 8 : bx; }
    unsigned char* ws = args.ws;
    unsigned* ctl = (unsigned*)(ws + WS_CTL);
    volatile LAS unsigned* MISC = (volatile LAS unsigned*)(C.lds + MISC_OFF);
    for (int u = C.tid; u < (LDS_BYTES - LDSCTL_OFF) / 4; u += 512) ((LAS unsigned*)(C.lds + LDSCTL_OFF))[u] = 0u;
    __syncthreads();
    XcdBarrier bar; bar.bar = ctl + CW_BAR; bar.x = 0; bar.st = nullptr;
    if (!MK_PER_PHASE) bar = xcd_barrier_post(ctl + CW_BAR, MISC + 8);
    const int lo = args.ph_lo, hi = args.ph_hi;
#ifndef MK_ONLY
#define MK_ONLY -1
#endif
#define IN(k) ((MK_ONLY < 0 || MK_ONLY == (k)) && lo <= (k) && (k) < hi)
#ifndef MK_T0
#define MK_T0 -1
#define MK_T1 -1
#endif
    unsigned long long ev_t0 = 0ull;
#define CLK(t) asm volatile("s_memrealtime %0\n\ts_waitcnt lgkmcnt(0)" : "=s"(t) :: "memory")
#define EV(id) do { if ((id) == MK_T0) { CLK(ev_t0); } if ((id) == MK_T1) { unsigned long long t1_; CLK(t1_); if (C.tid == 0 && (int)blockIdx.x == MK_KPROBE_BLK) MISC[14] = (unsigned)(t1_ - ev_t0); } } while (0)
#define SEAM(k) do { EV(2 * (k) + 1); if (!MK_PER_PHASE && IN((k) + 1)) xcd_barrier(bar); EV(2 * (k) + 2); } while (0)
#define DBL(k, ...) do { __VA_ARGS__; if (MK_DOUBLE == (k)) { __VA_ARGS__; } } while (0)

    const float* x_in = args.in[I_X]; float* X = args.out;
    float* MODSP = (float*)(ws + WS_MODSP); float* MODS = (float*)(ws + WS_MODS);
    float* COSR = (float*)(ws + WS_COSR); float* SINR = (float*)(ws + WS_SINR); float* COSM = (float*)(ws + WS_COSM); float* SINM = (float*)(ws + WS_SINM);
    float* RSTAT = (float*)(ws + WS_RSTAT); float* SSQKV = (float*)(ws + WS_SSQKV); float* SSQQ = (float*)(ws + WS_SSQQ);
    bf16* WFI = (bf16*)(ws + WS_WFI); bf16* WFO = (bf16*)(ws + WS_WFO); bf16* WRI = (bf16*)(ws + WS_WRI); bf16* WRO = (bf16*)(ws + WS_WRO);
    bf16* WDKV = (bf16*)(ws + WS_WDKV); bf16* WUKV = (bf16*)(ws + WS_WUKV); bf16* WDQ = (bf16*)(ws + WS_WDQ); bf16* WUQ = (bf16*)(ws + WS_WUQ); bf16* WMO = (bf16*)(ws + WS_WMO);
    bf16* H = (bf16*)(ws + WS_H); bf16* HK = (bf16*)(ws + WS_HK); bf16* A = (bf16*)(ws + WS_A);
    bf16* RQ = (bf16*)(ws + WS_RQ); bf16* RK = (bf16*)(ws + WS_RK); bf16* RV = (bf16*)(ws + WS_RV); bf16* RG = (bf16*)(ws + WS_RG); bf16* RO = (bf16*)(ws + WS_RO);
    bf16* CKVG = (bf16*)(ws + WS_CKVG); bf16* CQG = (bf16*)(ws + WS_CQG); bf16* KR = (bf16*)(ws + WS_KR); bf16* KN = (bf16*)(ws + WS_KN); bf16* VV = (bf16*)(ws + WS_VV);
    bf16* QQ = (bf16*)(ws + WS_QQ); bf16* AO = (bf16*)(ws + WS_AO);
    const float* norm_g = args.in[I_NORMG];

    EV(0);
    if (IN(0)) { DBL(0, prologue_phase(C, args, MODSP, WFI, WFO, WRI, WRO, WDKV, WUKV, WDQ, WUQ, WMO, COSR, SINR, COSM, SINM); SEAM(0)); }
    if (IN(1)) {
        const int gt = C.vcu * 512 + C.tid, NGT = C.G * 512;
        for (int i = gt; i < MODS_TOTAL; i += NGT) { float s = 0.f;
#pragma unroll
            for (int k = 0; k < 8; ++k) s += MODSP[(size_t)k * MODS_TOTAL + i];
            float bias; if (i < MODS_KV) { const int l = i / (4 * NMODV), n = i % NMODV; bias = args.in[I_ADAB][l * NMODV + n]; } else { bias = args.in[I_KVAB][(i - MODS_KV) % (2 * D)]; }
            MODS[i] = s + bias; }
        SEAM(1);
    }
#define MODL(l, k) (MODS + (size_t)(l) * 4 * NMODV + (size_t)(k) * D)
#define GEMMP(Aop, Bop, N_, K_, EpiT, ...) do { pg8::Gemm g_{(Aop), (Bop), M, (N_), (K_)}; pg8::PanelOrder S_; S_.init(M, (N_), C.G, (int)blockIdx.x); pg8::EpiT E_{__VA_ARGS__}; \
        pg8::gemm_phase<pg8::EpiT, pg8::PanelOrder>(C.lds, g_, S_, E_); } while (0)
#define GEMM(Aop, Bop, N_, K_, EpiT, ...) do { pg8::Gemm g_{(Aop), (Bop), M, (N_), (K_)}; pg8::StaticOrder S_; S_.init(M, (N_), C.G, (int)blockIdx.x); pg8::EpiT E_{__VA_ARGS__}; \
        pg8::gemm_phase<pg8::EpiT, pg8::StaticOrder>(C.lds, g_, S_, E_); } while (0)

    if (IN(2)) { norm_phase(C, x_in, norm_g + 0 * D, MODL(0, 0), MODL(0, 1), NMODV, H); SEAM(2); }
    if (IN(3)) { DBL(3, GEMM(H, WFI + 0 * WFI_ELEMS, 2 * FF, D, EpiSwiGLU, A); SEAM(3)); }
    if (IN(4)) { DBL(4, GEMMP(A, WFO + 0 * WFO_ELEMS, D, FF, EpiRes, x_in, X, MODL(0, 2), 0.5f); SEAM(4)); }
    if (IN(5)) { DBL(5, norm_phase(C, X, norm_g + 1 * D, MODL(0, 3), MODL(0, 4), NMODV, H); SEAM(5)); }
    if (IN(6)) { DBL(6, GEMM(H, WRI, RIN, D, EpiRet, RQ, RK, RV, RG, COSR, SINR); SEAM(6)); }
    if (IN(7)) { DBL(7, ret::retention_phase(C, RQ, RK, RV, RO, RSTAT); SEAM(7)); }
    if (IN(8)) { ret::gate_phase(C, RO, RG, RSTAT, args.in[I_RGN]); SEAM(8); }
    if (IN(9)) { GEMMP(RG, WRO, D, 4096, EpiRes, X, X, MODL(0, 5), 1.0f); SEAM(9); }
    if (IN(10)) { norm_phase(C, X, norm_g + 2 * D, MODL(0, 6), MODL(0, 7), NMODV, H); SEAM(10); }
    if (IN(11)) { GEMM(H, WFI + 1 * WFI_ELEMS, 2 * FF, D, EpiSwiGLU, A); SEAM(11); }
    if (IN(12)) { GEMMP(A, WFO + 1 * WFO_ELEMS, D, FF, EpiRes, X, X, MODL(0, 8), 0.5f); SEAM(12); }
    if (IN(13)) { norm_phase(C, X, args.in[I_KVNG], MODS + MODS_KV, MODS + MODS_KV + D, 2 * D, HK);
                  norm_phase(C, X, norm_g + 3 * D, MODL(1, 0), MODL(1, 1), NMODV, H); SEAM(13); }
    if (IN(14)) { GEMM(HK, WDKV, 768, D, EpiLatent, CKVG, args.in[I_KVLG], SSQKV, KR, COSM, SINM); SEAM(14); }
    if (IN(15)) { GEMM(CKVG, WUKV, 4096, 512, EpiUkv, KN, VV, SSQKV); EV(60);
                  GEMM(H, WFI + 2 * WFI_ELEMS, 2 * FF, D, EpiSwiGLU, A); SEAM(15); }
    if (IN(16)) { GEMMP(A, WFO + 2 * WFO_ELEMS, D, FF, EpiRes, X, X, MODL(1, 2), 0.5f); SEAM(16); }
    if (IN(17)) { norm_phase(C, X, norm_g + 4 * D, MODL(1, 3), MODL(1, 4), NMODV, H); SEAM(17); }
    if (IN(18)) { GEMM(H, WDQ, 512, D, EpiLatent, CQG, args.in[I_QLG], SSQQ, nullptr, nullptr, nullptr); SEAM(18); }
    if (IN(19)) { GEMM(CQG, WUQ, 3072, 512, EpiUq, QQ, SSQQ, COSM, SINM, 0.07216878364870322f * 1.4426950408889634f); SEAM(19); }
    if (IN(20)) { DBL(20, att::attention_phase(C, QQ, KN, KR, VV, AO); SEAM(20)); }
    if (IN(21)) { GEMMP(AO, WMO, D, D, EpiRes, X, X, MODL(1, 5), 1.0f); SEAM(21); }
    if (IN(22)) { norm_phase(C, X, norm_g + 5 * D, MODL(1, 6), MODL(1, 7), NMODV, H); SEAM(22); }
    if (IN(23)) { GEMM(H, WFI + 3 * WFI_ELEMS, 2 * FF, D, EpiSwiGLU, A); SEAM(23); }
    if (IN(24)) { GEMMP(A, WFO + 3 * WFO_ELEMS, D, FF, EpiRes, X, X, MODL(1, 8), 0.5f); SEAM(24); }
    if (IN(25)) { final_norm_phase(C, X, args.in[I_FING]); }
    EV(51);
    if (MK_T1 >= 0 && (int)blockIdx.x == MK_KPROBE_BLK && C.tid == 0) { const unsigned d = MISC[14]; const unsigned long long t0 = (unsigned long long)wall_clock64(); while ((unsigned long long)wall_clock64() - t0 < (unsigned long long)d) __builtin_amdgcn_s_sleep(8); }
#undef IN
#undef SEAM
}

extern "C" void kernel_launch(void* const* d_in, const int* in_sizes, int n_in, void* d_out, int out_size, void* d_ws, size_t ws_size, hipStream_t stream) {
    static int grid = 0;
    if (grid == 0) {
        if (n_in != 22 || in_sizes[0] != M * D || out_size != M * D || ws_size < WS_END) { fprintf(stderr, "kernel_launch: unexpected problem shape (n_in %d, in0 %d, out %d, ws %zu; need ws >= %zu)\n", n_in, n_in > 0 ? in_sizes[0] : -1, out_size, ws_size, (size_t)WS_END); grid = -1; return; }
        int dev = 0, cus = 0, per_cu = 0;
        if (hipGetDevice(&dev) != hipSuccess || hipDeviceGetAttribute(&cus, hipDeviceAttributeMultiprocessorCount, dev) != hipSuccess) { grid = -1; return; }
        if (hipFuncSetAttribute((const void*)mk_fwd, hipFuncAttributeMaxDynamicSharedMemorySize, LDS_BYTES) != hipSuccess) { fprintf(stderr, "kernel_launch: hipFuncSetAttribute failed\n"); grid = -1; return; }
        if (hipOccupancyMaxActiveBlocksPerMultiprocessor(&per_cu, (const void*)mk_fwd, 512, LDS_BYTES) != hipSuccess || per_cu < 1)
            fprintf(stderr, "kernel_launch: note: occupancy query reports %d workgroups per CU\n", per_cu);
        (void)hipGetLastError();
        grid = cus;
    }
    if (grid < 0) return;
    if (hipMemsetAsync((char*)d_ws + WS_CTL, 0, CTL_ZERO_BYTES, stream) != hipSuccess) return;
    Args a{};
    for (int i = 0; i < 22; ++i) a.in[i] = (const float*)d_in[i];
    a.out = (float*)d_out; a.ws = (unsigned char*)d_ws;
#if MK_PER_PHASE
    for (int p = 0; p < N_PHASES; ++p) { a.ph_lo = p; a.ph_hi = p + 1; hipLaunchKernelGGL(mk_fwd, dim3(grid), dim3(512), LDS_BYTES, stream, a); }
#else
    a.ph_lo = 0; a.ph_hi = N_PHASES;
    hipLaunchKernelGGL(mk_fwd, dim3(grid), dim3(512), LDS_BYTES, stream, a);
#endif
    const hipError_t le = hipPeekAtLastError();
    if (le != hipSuccess) fprintf(stderr, "kernel_launch: launch failed: %s\n", hipGetErrorName(le));
}
```

```cpp
#include <hip/hip_runtime.h>
#include <cstdio>
#include <cstdint>

#ifndef MK_PER_PHASE
#define MK_PER_PHASE 0
#endif

#define MK_KPROBE_BLK 0
#ifndef MK_DOUBLE
#define MK_DOUBLE -1
#endif
#define GAS __attribute__((address_space(1)))
#define LAS __attribute__((address_space(3)))
typedef unsigned short bf16;
typedef short bf16x8 __attribute__((ext_vector_type(8)));
typedef short s16x4 __attribute__((ext_vector_type(4)));
typedef short v4i16_t __attribute__((ext_vector_type(4)));
typedef float f32x2 __attribute__((ext_vector_type(2)));
typedef float f32x4 __attribute__((ext_vector_type(4)));
typedef float f32x16 __attribute__((ext_vector_type(16)));
typedef unsigned u32x2 __attribute__((ext_vector_type(2)));
typedef unsigned u32x4 __attribute__((ext_vector_type(4)));
typedef __bf16 bf16x2_t __attribute__((ext_vector_type(2)));

constexpr int BATCH = 4, SEQ = 4096, M = BATCH * SEQ, D = 2048, FF = 5632, NMODV = 9 * D;
constexpr int RIN = 12288;
constexpr int MH = 16, QRANK = 512, KVRANK = 512;
constexpr float EPS = 1e-6f;
constexpr int MODS_TOTAL = 8 * NMODV + 4 * 2 * D;
constexpr int MODS_KV = 8 * NMODV;
constexpr int NCOLS_MODS = 2 * NMODV + 2 * D;

constexpr size_t MiB = 1u << 20;
constexpr size_t WS_CTL = 0, CTL_ZERO_BYTES = 1 * MiB;
constexpr size_t WS_MODSP = 1 * MiB, WS_MODS = 6 * MiB;
constexpr size_t WS_COSR = 7 * MiB, WS_SINR = 15 * MiB, WS_COSM = 23 * MiB, WS_SINM = 25 * MiB;
constexpr size_t WS_RSTAT = 27 * MiB, WS_SSQKV = 35 * MiB, WS_SSQQ = 35 * MiB + 512 * 1024;
constexpr size_t WS_WFI = 36 * MiB, WS_WFO = 212 * MiB, WS_WRI = 300 * MiB, WS_WRO = 348 * MiB, WS_WDKV = 364 * MiB, WS_WUKV = 367 * MiB,
                 WS_WDQ = 371 * MiB, WS_WUQ = 373 * MiB, WS_WMO = 376 * MiB;
constexpr size_t WS_H = 384 * MiB, WS_HK = 448 * MiB;
constexpr size_t WS_RA = 512 * MiB;
constexpr size_t WS_A = WS_RA, WS_RQ = WS_RA, WS_RK = WS_RA + 64 * MiB, WS_QQ = WS_RA, WS_AO = WS_RA + 96 * MiB;
constexpr size_t WS_RB = 688 * MiB;
constexpr size_t WS_RV = WS_RB, WS_RG = WS_RB + 128 * MiB, WS_RO = WS_RB + 256 * MiB;
constexpr size_t WS_CKVG = WS_RB, WS_CQG = WS_RB + 16 * MiB, WS_KR = WS_RB + 32 * MiB, WS_KN = WS_RB + 36 * MiB, WS_VV = WS_RB + 100 * MiB;
constexpr size_t WS_END = 1072 * MiB;
constexpr size_t WFI_ELEMS = (size_t)2 * FF * D, WFO_ELEMS = (size_t)D * FF;
constexpr int CW_TMO = 0, CW_BAR = 4096;

constexpr int RING_BYTES = 143360, LDSCTL_OFF = RING_BYTES, MISC_OFF = LDSCTL_OFF + 320, LDS_BYTES = 147456;

#define LDS_WAIT() asm volatile("s_waitcnt lgkmcnt(0)" ::: "memory")
#define VM_WAIT() asm volatile("s_waitcnt vmcnt(0)" ::: "memory")
__device__ __forceinline__ unsigned f2bf(float f) { unsigned u = __builtin_bit_cast(unsigned, f); return (u + 0x7fffu + ((u >> 16) & 1u)) >> 16; }
__device__ __forceinline__ unsigned pk2(float lo, float hi) { f32x2 v = {lo, hi}; bf16x2_t b = __builtin_convertvector(v, bf16x2_t); return __builtin_bit_cast(unsigned, b); }
__device__ __forceinline__ float bf_lo(unsigned w) { return __builtin_bit_cast(float, w << 16); }
__device__ __forceinline__ float bf_hi(unsigned w) { return __builtin_bit_cast(float, w & 0xffff0000u); }
__device__ __forceinline__ float silu_f(float x) { return x * __builtin_amdgcn_rcpf(1.0f + __builtin_amdgcn_exp2f(-1.4426950408889634f * x)); }
__device__ __forceinline__ float wave_sum(float v) {
#pragma unroll
    for (int o = 1; o < 64; o <<= 1) v += __shfl_xor(v, o);
    return v;
}

namespace pg8 {
typedef unsigned short bf16_t;
constexpr int BM = 256, BK = 64, HALF = 128, HTB = HALF * BK * 2, STAGE_BYTES = 8 * HTB, NXCD = 8, WGM = 8;
__host__ __device__ __forceinline__ int lds_byte(int r, int c) { const int st = (r >> 4) * 2 + (c >> 5), rr = r & 15, cc = c & 31, ob = rr * 64 + cc * 2; return st * 1024 + (ob ^ (((ob >> 9) & 1) << 5)); }
__host__ __device__ __forceinline__ void stage_rc(int b, int& R, int& C) { const int st = b / 1024, sb = b % 1024, swz = sb ^ (((sb >> 9) & 1) << 5); R = (st >> 1) * 16 + swz / 64; C = (st & 1) * 32 + (swz % 64) / 2; }
__host__ __device__ __forceinline__ int perm32(int rho) { const int n = rho >> 4, i = rho & 15; return 8 * (i >> 2) + 4 * n + (i & 3); }
struct Unit { int pm, pn; };
struct Gemm { const bf16_t* A; const bf16_t* Bt; int M, N, K; };
struct StaticOrder {
    int nM, nN, nwg, G, c;
    __host__ __device__ void init(int M_, int N_, int G_, int c_) { nM = M_ / BM; nN = N_ / BM; nwg = nM * nN; G = G_; c = c_; }
    __host__ __device__ __forceinline__ bool next(int i, Unit& u) const {
        const long L = (long)i * G + c; if (L >= nwg) return false;
        int wgid = (int)L; { const int q = nwg / NXCD, r = nwg % NXCD, xcd = wgid % NXCD, off = wgid / NXCD; wgid = (xcd < r ? xcd * (q + 1) : r * (q + 1) + (xcd - r) * q) + off; }
        const int nig = WGM * nN, gid = wgid / nig, fm = gid * WGM, gsz = (nM - fm) < WGM ? (nM - fm) : WGM;
        u.pm = fm + ((wgid % nig) % gsz); u.pn = (wgid % nig) / gsz; return true;
    }
    __device__ __forceinline__ void a_ready(const Unit&) const {}
    __device__ __forceinline__ void done(const Unit&) const {}
};
struct PanelOrder {
    int nM, nN, G, c;
    __host__ __device__ void init(int M_, int N_, int G_, int c_) { nM = M_ / BM; nN = N_ / BM; G = G_; c = c_; }
    __host__ __device__ __forceinline__ bool next(int i, Unit& u) const {
        const int x = c & 7, j = c >> 3, ppr = G >> 3;
        const int pm = i * ppr + x * (ppr >> 3) + (j >> 3);
        if (pm >= nM) return false;
        u.pm = pm; u.pn = j & 7; return true;
    }
    __device__ __forceinline__ void a_ready(const Unit&) const {}
    __device__ __forceinline__ void done(const Unit&) const {}
};
struct SkewOrder {
    int nM, nN, G, c;
    __host__ __device__ __forceinline__ void init(int M_, int N_, int G_, int c_) { nM = M_ / BM; nN = N_ / BM; G = G_; c = c_; }
    __host__ __device__ __forceinline__ bool next(int i, Unit& u) const {
        const int half = G >> 1, nwg = nM * nN, big = (nwg * 5) / (8 * half), small_ = (nwg - big * half) / half;
        int id;
        if (c >= half) { if (i >= big) return false; id = (c - half) * big + i; } else { if (i >= small_) return false; id = half * big + c * small_ + i; }
        if (id >= nwg) return false;
        u.pm = id / nN; u.pn = id % nN; return true;
    }
    __device__ __forceinline__ void a_ready(const Unit&) const {}
    __device__ __forceinline__ void done(const Unit&) const {}
};
template <class Epi, class Sched>
__device__ __forceinline__ void gemm_phase(LAS unsigned char* lds, const Gemm g, const Sched& S, const Epi& E) {
    const int tid = threadIdx.x, wid = __builtin_amdgcn_readfirstlane(tid >> 6), lane = tid & 63, wr = wid >> 2, wc = wid & 3, fr = lane & 15, fq = lane >> 4;
    const int K = g.K, nt = K / BK;
    unsigned voffA[2], voffB[2];
#pragma unroll
    for (int i = 0; i < 2; ++i) { int R, C; stage_rc(tid * 16 + i * 8192, R, C); const int Rb = Epi::PERM ? ((R & ~31) + perm32(R & 31)) : R;
        voffA[i] = (unsigned)(R * K + C) * 2u; voffB[i] = (unsigned)(Rb * K + C) * 2u; }
    const size_t kstep = (size_t)(BK * 2);
    const size_t hstep = (size_t)HALF * K * 2;
    const size_t tstep = 2 * hstep;
    const unsigned ldsw = (unsigned)wid * 1024u;
    const int aoff = lds_byte(wr * 64 + fr, fq * 8), boff = lds_byte(wc * 32 + fr, fq * 8);
#define PG8_SA(b, h) (((b) * 2 + (h)) * HTB)
#define PG8_SB(b, h) ((4 + (b) * 2 + (h)) * HTB)
#define PG8_STAGE(bufoff, gbase, voff) do { _Pragma("unroll") for (int _i = 0; _i < 2; ++_i) \
        __builtin_amdgcn_global_load_lds((const unsigned*)((const char*)(gbase) + (voff)[_i]), (LAS unsigned*)(lds + (bufoff) + ldsw + _i * 8192), 16, 0, 0); } while (0)
#define PG8_LDA(dst, b, h) do { _Pragma("unroll") for (int m = 0; m < 4; ++m) _Pragma("unroll") for (int k = 0; k < 2; ++k) dst[m][k] = *(const LAS bf16x8*)(lds + PG8_SA(b, h) + aoff + m * 2048 + k * 1024); } while (0)
#define PG8_LDB(dst, b, h) do { _Pragma("unroll") for (int n = 0; n < 2; ++n) _Pragma("unroll") for (int k = 0; k < 2; ++k) dst[n][k] = *(const LAS bf16x8*)(lds + PG8_SB(b, h) + boff + n * 2048 + k * 1024); } while (0)
#define PG8_MMA(ai, bj, At, Bt) do { __builtin_amdgcn_s_setprio(1); _Pragma("unroll") for (int m = 0; m < 4; ++m) _Pragma("unroll") for (int n = 0; n < 2; ++n) _Pragma("unroll") for (int k = 0; k < 2; ++k) \
        acc[ai][bj][m][n] = __builtin_amdgcn_mfma_f32_16x16x32_bf16(Bt[n][k], At[m][k], acc[ai][bj][m][n], 0, 0, 0); __builtin_amdgcn_s_setprio(0); } while (0)
#define PG8_WAIT_V(n) asm volatile("s_waitcnt vmcnt(" #n ")" ::: "memory")
#define PG8_WAIT_L(n) asm volatile("s_waitcnt lgkmcnt(" #n ")" ::: "memory")
#define PG8_BAR __builtin_amdgcn_s_barrier()
#define PG8_SCHED __builtin_amdgcn_sched_barrier(0)
    Unit cur, nxt; int ui = 0;
    if (!S.next(0, cur)) return;
    f32x4 acc[2][2][4][2];
#pragma unroll
    for (int a = 0; a < 2; ++a)
#pragma unroll
        for (int b = 0; b < 2; ++b)
#pragma unroll
            for (int m = 0; m < 4; ++m)
#pragma unroll
                for (int n = 0; n < 2; ++n) acc[a][b][m][n] = (f32x4){0.f, 0.f, 0.f, 0.f};
    bf16x8 At[4][2], B0[2][2], B1[2][2];
    const char* cA = (const char*)g.A + (size_t)cur.pm * tstep; const char* cB = (const char*)g.Bt + (size_t)cur.pn * tstep;
    S.a_ready(cur);
    PG8_STAGE(PG8_SB(0, 0), cB, voffB); PG8_STAGE(PG8_SB(0, 1), cB + hstep, voffB); PG8_STAGE(PG8_SA(0, 0), cA, voffA); PG8_STAGE(PG8_SA(0, 1), cA + hstep, voffA);
    if (wr == 1) PG8_BAR;
    PG8_WAIT_V(2); PG8_BAR;
    PG8_STAGE(PG8_SB(1, 0), cB + kstep, voffB); PG8_STAGE(PG8_SA(1, 0), cA + kstep, voffA); PG8_STAGE(PG8_SB(1, 1), cB + hstep + kstep, voffB);
    PG8_WAIT_V(6); PG8_BAR;
    for (;;) {
        const bool has_next = S.next(ui + 1, nxt);
        const char* nA = has_next ? (const char*)g.A + (size_t)nxt.pm * tstep : cA; const char* nB = has_next ? (const char*)g.Bt + (size_t)nxt.pn * tstep : cB;
        for (int t = 0; t < nt; t += 2) {
            const bool last = (t == nt - 2);
            const char* a1 = cA + (size_t)(t + 1) * kstep;
            const char* a2 = last ? nA : cA + (size_t)(t + 2) * kstep; const char* b2 = last ? nB : cB + (size_t)(t + 2) * kstep;
            const char* a3 = a2 + kstep; const char* b3 = b2 + kstep;
            if (last && has_next) S.a_ready(nxt);
            PG8_LDB(B0, 0, 0); PG8_LDB(B1, 0, 1); PG8_SCHED; PG8_LDA(At, 0, 0); PG8_STAGE(PG8_SA(1, 1), a1 + hstep, voffA);
            PG8_WAIT_V(8); PG8_WAIT_L(0); PG8_BAR; PG8_MMA(0, 0, At, B0); PG8_MMA(0, 1, At, B1); PG8_BAR; PG8_SCHED;
            PG8_LDA(At, 0, 1); PG8_STAGE(PG8_SB(0, 0), b2, voffB); PG8_STAGE(PG8_SB(0, 1), b2 + hstep, voffB); PG8_STAGE(PG8_SA(0, 0), a2, voffA);
            PG8_WAIT_V(8); PG8_WAIT_L(0); PG8_BAR; PG8_MMA(1, 0, At, B0); PG8_MMA(1, 1, At, B1); PG8_BAR; PG8_SCHED;
            PG8_LDB(B0, 1, 0); PG8_LDB(B1, 1, 1); PG8_SCHED; PG8_LDA(At, 1, 0); PG8_STAGE(PG8_SA(0, 1), a2 + hstep, voffA);
            PG8_WAIT_V(8); PG8_WAIT_L(0); PG8_BAR; PG8_MMA(0, 0, At, B0); PG8_MMA(0, 1, At, B1); PG8_BAR; PG8_SCHED;
            PG8_LDA(At, 1, 1); PG8_STAGE(PG8_SB(1, 0), b3, voffB); PG8_STAGE(PG8_SB(1, 1), b3 + hstep, voffB); PG8_STAGE(PG8_SA(1, 0), a3, voffA);
            PG8_WAIT_V(8); PG8_WAIT_L(0); PG8_BAR; PG8_MMA(1, 0, At, B0); PG8_MMA(1, 1, At, B1); PG8_BAR; PG8_SCHED;
        }
        if (wr == 0) PG8_BAR;
        E(acc, cur, wr, wc, fr, fq); S.done(cur);
        if (!has_next) break;
#pragma unroll
        for (int a = 0; a < 2; ++a)
#pragma unroll
            for (int b = 0; b < 2; ++b)
#pragma unroll
                for (int m = 0; m < 4; ++m)
#pragma unroll
                    for (int n = 0; n < 2; ++n) acc[a][b][m][n] = (f32x4){0.f, 0.f, 0.f, 0.f};
        cur = nxt; cA = nA; cB = nB; ++ui;
        if (wr == 1) PG8_BAR;
    }
    PG8_WAIT_V(0);
    PG8_BAR;
#undef PG8_SA
#undef PG8_SB
#undef PG8_STAGE
#undef PG8_LDA
#undef PG8_LDB
#undef PG8_MMA
#undef PG8_WAIT_V
#undef PG8_WAIT_L
#undef PG8_BAR
#undef PG8_SCHED
}

typedef const f32x4 (&AccRef)[2][2][4][2];
__device__ __forceinline__ u32x4 pack8(f32x4 v0, f32x4 v1) { u32x4 w; w.x = pk2(v0[0], v0[1]); w.y = pk2(v0[2], v0[3]); w.z = pk2(v1[0], v1[1]); w.w = pk2(v1[2], v1[3]); return w; }

struct EpiSwiGLU {
    static constexpr bool PERM = true; bf16_t* O;
    __device__ __forceinline__ void operator()(AccRef acc, const Unit& u, int wr, int wc, int fr, int fq) const {
        const int row0 = u.pm * BM + wr * 64 + fr, col0 = u.pn * 128 + wc * 32 + 8 * fq;
#pragma unroll
        for (int ai = 0; ai < 2; ++ai)
#pragma unroll
            for (int m = 0; m < 4; ++m) { bf16_t* rowp = O + (size_t)(row0 + ai * HALF + m * 16) * FF + col0;
                f32x4 v0, v1;
#pragma unroll
                for (int e = 0; e < 4; ++e) { v0[e] = silu_f(acc[ai][0][m][0][e]) * acc[ai][1][m][0][e]; v1[e] = silu_f(acc[ai][0][m][1][e]) * acc[ai][1][m][1][e]; }
                *(u32x4*)rowp = pack8(v0, v1); }
    }
};
struct EpiRes {
    static constexpr bool PERM = true; const float* base; float* out; const float* gate; float gmul;
    __device__ __forceinline__ void operator()(AccRef acc, const Unit& u, int wr, int wc, int fr, int fq) const {
        const int row0 = u.pm * BM + wr * 64 + fr, col0 = u.pn * BM + wc * 32 + 8 * fq;
        const float* gp = gate + (size_t)(u.pm >> 4) * NMODV + col0;
        f32x4 gv[2][2];
#pragma unroll
        for (int bj = 0; bj < 2; ++bj)
#pragma unroll
            for (int n = 0; n < 2; ++n) gv[bj][n] = *(const f32x4*)(gp + bj * HALF + n * 4) * gmul;
#pragma unroll
        for (int ai = 0; ai < 2; ++ai)
#pragma unroll
            for (int m = 0; m < 4; ++m) { const size_t off = (size_t)(row0 + ai * HALF + m * 16) * D + col0;
#pragma unroll
                for (int bj = 0; bj < 2; ++bj)
#pragma unroll
                    for (int n = 0; n < 2; ++n) { const f32x4 bs = *(const f32x4*)(base + off + bj * HALF + n * 4); *(f32x4*)(out + off + bj * HALF + n * 4) = bs + gv[bj][n] * acc[ai][bj][m][n]; } }
    }
};
struct EpiRet {
    static constexpr bool PERM = true; bf16_t *RQ, *RK, *RV, *RG; const float *COS, *SIN;
    __device__ __forceinline__ void operator()(AccRef acc, const Unit& u, int wr, int wc, int fr, int fq) const {
        const int row0 = u.pm * BM + wr * 64 + fr, i0 = wc * 32 + 8 * fq;
        if (u.pn < 16) {
            bf16_t* dst = (u.pn < 8 ? RQ : RK) + (u.pn & 7) * 256 + i0; const float sc = u.pn < 8 ? 0.0625f : 1.0f;
#pragma unroll
            for (int ai = 0; ai < 2; ++ai)
#pragma unroll
                for (int m = 0; m < 4; ++m) { const int r = row0 + ai * HALF + m * 16;
                    const f32x4 c0 = *(const f32x4*)(COS + (size_t)r * 128 + i0), c1 = *(const f32x4*)(COS + (size_t)r * 128 + i0 + 4);
                    const f32x4 s0 = *(const f32x4*)(SIN + (size_t)r * 128 + i0), s1 = *(const f32x4*)(SIN + (size_t)r * 128 + i0 + 4);
                    const f32x4 x10 = acc[ai][0][m][0], x11 = acc[ai][0][m][1], x20 = acc[ai][1][m][0], x21 = acc[ai][1][m][1];
                    const f32x4 o10 = (x10 * c0 - x20 * s0) * sc, o11 = (x11 * c1 - x21 * s1) * sc, o20 = (x10 * s0 + x20 * c0) * sc, o21 = (x11 * s1 + x21 * c1) * sc;
                    *(u32x4*)(dst + (size_t)r * D) = pack8(o10, o11); *(u32x4*)(dst + (size_t)r * D + 128) = pack8(o20, o21); }
        } else {
            const bool isg = u.pn >= 32; bf16_t* dst = (isg ? RG : RV) + ((u.pn - 16) & 15) * 256 + i0;
#pragma unroll
            for (int ai = 0; ai < 2; ++ai)
#pragma unroll
                for (int m = 0; m < 4; ++m) { bf16_t* rowp = dst + (size_t)(row0 + ai * HALF + m * 16) * 4096;
#pragma unroll
                    for (int bj = 0; bj < 2; ++bj) { f32x4 v0 = acc[ai][bj][m][0], v1 = acc[ai][bj][m][1];
                        if (isg) {
#pragma unroll
                            for (int e = 0; e < 4; ++e) { v0[e] = silu_f(v0[e]); v1[e] = silu_f(v1[e]); } }
                        *(u32x4*)(rowp + bj * HALF) = pack8(v0, v1); } }
        }
    }
};
struct EpiLatent {
    static constexpr bool PERM = false; bf16_t* O; const float* g; float* ssq; bf16_t* KR; const float *COS, *SIN;
    __device__ __forceinline__ void operator()(AccRef acc, const Unit& u, int wr, int wc, int fr, int fq) const {
        const int row0 = u.pm * BM + wr * 64 + fr;
        if (u.pn < 2) {
            const int col0 = u.pn * BM + wc * 32 + 4 * fq;
            f32x4 gv[2][2];
#pragma unroll
            for (int bj = 0; bj < 2; ++bj)
#pragma unroll
                for (int n = 0; n < 2; ++n) gv[bj][n] = *(const f32x4*)(g + col0 + bj * HALF + n * 16);
#pragma unroll
            for (int ai = 0; ai < 2; ++ai)
#pragma unroll
                for (int m = 0; m < 4; ++m) { const int r = row0 + ai * HALF + m * 16; float s = 0.f;
#pragma unroll
                    for (int bj = 0; bj < 2; ++bj)
#pragma unroll
                        for (int n = 0; n < 2; ++n) { const f32x4 a = acc[ai][bj][m][n]; s += (a[0] * a[0] + a[1] * a[1]) + (a[2] * a[2] + a[3] * a[3]); const f32x4 v = a * gv[bj][n];
                            u32x2 w; w.x = pk2(v[0], v[1]); w.y = pk2(v[2], v[3]); *(u32x2*)(O + (size_t)r * 512 + col0 + bj * HALF + n * 16) = w; }
                    s += __shfl_xor(s, 16); s += __shfl_xor(s, 32);
                    if (fq == 0) ssq[(size_t)r * 8 + u.pn * 4 + wc] = s; }
        } else if (wc == 0) {
#pragma unroll
            for (int ai = 0; ai < 2; ++ai)
#pragma unroll
                for (int m = 0; m < 4; ++m) { const int r = row0 + ai * HALF + m * 16;
#pragma unroll
                    for (int n = 0; n < 2; ++n) { const int i = 16 * n + 4 * fq;
                        const f32x4 c = *(const f32x4*)(COS + (size_t)r * 32 + i), s = *(const f32x4*)(SIN + (size_t)r * 32 + i);
                        const f32x4 x1 = acc[ai][0][m][n], x2 = acc[ai][1][m][n]; const f32x4 o1 = x1 * c - x2 * s, o2 = x1 * s + x2 * c;
                        u32x2 w1, w2; w1.x = pk2(o1[0], o1[1]); w1.y = pk2(o1[2], o1[3]); w2.x = pk2(o2[0], o2[1]); w2.y = pk2(o2[2], o2[3]);
                        *(u32x2*)(KR + (size_t)r * 64 + i) = w1; *(u32x2*)(KR + (size_t)r * 64 + 32 + i) = w2; } }
        }
    }
};
__device__ __forceinline__ float row_rstd8(const float* ssq, int r, float inv_n) {
    const f32x4 a = *(const f32x4*)(ssq + (size_t)r * 8), b = *(const f32x4*)(ssq + (size_t)r * 8 + 4);
    return __builtin_amdgcn_rsqf(((a[0] + a[1]) + (a[2] + a[3]) + (b[0] + b[1]) + (b[2] + b[3])) * inv_n + EPS);
}
struct EpiUkv {
    static constexpr bool PERM = true; bf16_t *KN, *VV; const float* ssq;
    __device__ __forceinline__ void operator()(AccRef acc, const Unit& u, int wr, int wc, int fr, int fq) const {
        const int row0 = u.pm * BM + wr * 64 + fr, col0 = u.pn * 128 + wc * 32 + 8 * fq;
#pragma unroll
        for (int ai = 0; ai < 2; ++ai)
#pragma unroll
            for (int m = 0; m < 4; ++m) { const int r = row0 + ai * HALF + m * 16; const float rs = row_rstd8(ssq, r, 1.0f / 512.0f);
                *(u32x4*)(KN + (size_t)r * 2048 + col0) = pack8(acc[ai][0][m][0] * rs, acc[ai][0][m][1] * rs);
                *(u32x4*)(VV + (size_t)r * 2048 + col0) = pack8(acc[ai][1][m][0] * rs, acc[ai][1][m][1] * rs); }
    }
};
struct EpiUq {
    static constexpr bool PERM = true; bf16_t* Q; const float* ssq; const float *COS, *SIN; float qscale;
    __device__ __forceinline__ void operator()(AccRef acc, const Unit& u, int wr, int wc, int fr, int fq) const {
        const int row0 = u.pm * BM + wr * 64 + fr;
        if (u.pn < 8) {
            const int col0 = wc * 32 + 8 * fq;
#pragma unroll
            for (int ai = 0; ai < 2; ++ai)
#pragma unroll
                for (int m = 0; m < 4; ++m) { const int r = row0 + ai * HALF + m * 16; const float rs = row_rstd8(ssq, r, 1.0f / 512.0f) * qscale;
#pragma unroll
                    for (int bj = 0; bj < 2; ++bj) *(u32x4*)(Q + (size_t)r * 3072 + (2 * u.pn + bj) * 192 + col0) = pack8(acc[ai][bj][m][0] * rs, acc[ai][bj][m][1] * rs); }
        } else {
            const int head = 4 * (u.pn - 8) + wc, i0 = 8 * fq;
#pragma unroll
            for (int ai = 0; ai < 2; ++ai)
#pragma unroll
                for (int m = 0; m < 4; ++m) { const int r = row0 + ai * HALF + m * 16; const float rs = row_rstd8(ssq, r, 1.0f / 512.0f) * qscale;
                    const f32x4 c0 = *(const f32x4*)(COS + (size_t)r * 32 + i0), c1 = *(const f32x4*)(COS + (size_t)r * 32 + i0 + 4);
                    const f32x4 s0 = *(const f32x4*)(SIN + (size_t)r * 32 + i0), s1 = *(const f32x4*)(SIN + (size_t)r * 32 + i0 + 4);
                    const f32x4 x10 = acc[ai][0][m][0], x11 = acc[ai][0][m][1], x20 = acc[ai][1][m][0], x21 = acc[ai][1][m][1];
                    const f32x4 o10 = (x10 * c0 - x20 * s0) * rs, o11 = (x11 * c1 - x21 * s1) * rs, o20 = (x10 * s0 + x20 * c0) * rs, o21 = (x11 * s1 + x21 * c1) * rs;
                    bf16_t* qp = Q + (size_t)r * 3072 + head * 192 + 128 + i0;
                    *(u32x4*)qp = pack8(o10, o11); *(u32x4*)(qp + 32) = pack8(o20, o21); }
        }
    }
};
}

#define XB_TMO      128
#define XB_XCNT(j)  (256  + 64 * (j))
#define XB_XSUB(j)  (1280 + 64 * (j))
#define XB_XGEN(j)  (2304 + 64 * (j))
#define XB_TOP      3328
#define XB_TOPGEN   3392
#define XCD_BAR_WORDS 3456
#define XB_SPIN_CAP (1u << 20)
__device__ __forceinline__ unsigned xb_ld(unsigned* p)              { return __hip_atomic_load(p, __ATOMIC_RELAXED, __HIP_MEMORY_SCOPE_AGENT); }
__device__ __forceinline__ unsigned xb_add(unsigned* p, unsigned v) { return __hip_atomic_fetch_add(p, v, __ATOMIC_RELAXED, __HIP_MEMORY_SCOPE_AGENT); }
__device__ __forceinline__ unsigned xb_xcc_id() { return (unsigned)__builtin_amdgcn_s_getreg((3 << 11) | 20) & 0xFu; }
#define XB_SPIN(cond, bar) do { unsigned _sp = 0; while (cond) { __builtin_amdgcn_s_sleep(1); \
    if ((++_sp & 255u) == 0u) { if (xb_ld(&(bar)[XB_TMO])) break; if (_sp > XB_SPIN_CAP) { atomicAdd(&(bar)[XB_TMO], 1u); break; } } } } while (0)
struct XcdBarrier { unsigned* bar; unsigned x; volatile LAS unsigned* st; };
__device__ __forceinline__ XcdBarrier xcd_barrier_post(unsigned* bar, volatile LAS unsigned* st) {
    XcdBarrier b; b.bar = bar; b.x = xb_xcc_id(); b.st = st;
    if (threadIdx.x == 0) (void)xb_add(&bar[XB_XCNT(b.x)], 1u);
    return b;
}
__device__ __forceinline__ void xcd_barrier_complete(unsigned* bar, unsigned x, unsigned& nloc, unsigned& nx) {
    const unsigned G = gridDim.x * gridDim.y * gridDim.z;
    unsigned sum, cnt, mine, sp = 0u;
    for (;;) {
        sum = 0u; cnt = 0u; mine = 0u;
#pragma unroll
        for (unsigned j = 0; j < 16; ++j) { const unsigned c = xb_ld(&bar[XB_XCNT(j)]); sum += c; cnt += (c > 0u) ? 1u : 0u; mine = (j == x) ? c : mine; }
        if (sum == G) break;
        __builtin_amdgcn_s_sleep(1);
        if ((++sp & 255u) == 0u) { if (xb_ld(&bar[XB_TMO])) break; if (sp > XB_SPIN_CAP) { atomicAdd(&bar[XB_TMO], 1u); break; } }
    }
    nloc = mine > 0u ? mine : 1u; nx = cnt > 0u ? cnt : 1u;
}
__device__ __forceinline__ void xcd_barrier(const XcdBarrier& b) {
    asm volatile("s_waitcnt vmcnt(0)" ::: "memory");
    __syncthreads();
    if (threadIdx.x == 0) {
        unsigned* bar = b.bar;
        __builtin_amdgcn_s_waitcnt(0);
        unsigned nloc = b.st[0], nx = b.st[1];
        if (nloc == 0u) { xcd_barrier_complete(bar, b.x, nloc, nx); b.st[0] = nloc; b.st[1] = nx; }
        const unsigned old = xb_add(&bar[XB_XSUB(b.x)], 1u);
        const unsigned gen = old / nloc;
        if (old + 1u == (gen + 1u) * nloc) {
            __builtin_amdgcn_fence(__ATOMIC_RELEASE, "agent");
            asm volatile("s_waitcnt vmcnt(0)" ::: "memory");
            const unsigned og = xb_add(&bar[XB_TOP], 1u);
            const unsigned tg = og / nx;
            if (og + 1u == (tg + 1u) * nx) xb_add(&bar[XB_TOPGEN], 1u);
            else XB_SPIN(xb_ld(&bar[XB_TOPGEN]) == tg, bar);
            __builtin_amdgcn_fence(__ATOMIC_ACQUIRE, "agent");
            xb_add(&bar[XB_XGEN(b.x)], 1u);
            asm volatile("s_waitcnt vmcnt(0)" ::: "memory");
        } else {
            XB_SPIN(xb_ld(&bar[XB_XGEN(b.x)]) == gen, bar);
            __builtin_amdgcn_fence(__ATOMIC_ACQUIRE, "agent");
            asm volatile("s_waitcnt vmcnt(0)" ::: "memory");
        }
    }
    __syncthreads();
}

struct Ctx { LAS unsigned char* lds; int tid, lane, wave, vcu, G; };

__device__ __forceinline__ int mods_index(int n, int b) {
    if (n < NMODV) return b * NMODV + n;
    if (n < 2 * NMODV) return (4 + b) * NMODV + (n - NMODV);
    return MODS_KV + b * 2 * D + (n - 2 * NMODV);
}
__device__ __forceinline__ void mods_item(const Ctx& C, int item, const float* ada_w, const float* kv_ada_w, float* modsp) {
    const int cb = item % (NCOLS_MODS / 32), ks = item / (NCOLS_MODS / 32), n0 = cb * 32;
    const float* W; int ldw, col;
    if (n0 < NMODV) { W = ada_w; ldw = NMODV; col = n0; } else if (n0 < 2 * NMODV) { W = ada_w + (size_t)D * NMODV; ldw = NMODV; col = n0 - NMODV; } else { W = kv_ada_w; ldw = 2 * D; col = n0 - 2 * NMODV; }
    const int kr = C.lane >> 3, c4 = 4 * (C.lane & 7);
    const LAS float* cact = (const LAS float*)C.lds;
    f32x4 a0 = {0.f, 0.f, 0.f, 0.f}, a1 = a0, a2 = a0, a3 = a0;
    const float* wp = W + (size_t)(ks * 256 + kr) * ldw + col + c4;
#pragma unroll 8
    for (int it = 0; it < 32; ++it) { const f32x4 w = *(const f32x4*)(wp + (size_t)it * 8 * ldw); const int k = ks * 256 + it * 8 + kr;
        a0 += w * cact[k]; a1 += w * cact[2048 + k]; a2 += w * cact[4096 + k]; a3 += w * cact[6144 + k]; }
#pragma unroll
    for (int e = 0; e < 4; ++e) {
#pragma unroll
        for (int o = 8; o < 64; o <<= 1) { a0[e] += __shfl_xor(a0[e], o); a1[e] += __shfl_xor(a1[e], o); a2[e] += __shfl_xor(a2[e], o); a3[e] += __shfl_xor(a3[e], o); } }
    if (C.lane < 8) { float* o = modsp + (size_t)ks * MODS_TOTAL;
        *(f32x4*)(o + mods_index(n0 + c4, 0)) = a0; *(f32x4*)(o + mods_index(n0 + c4, 1)) = a1; *(f32x4*)(o + mods_index(n0 + c4, 2)) = a2; *(f32x4*)(o + mods_index(n0 + c4, 3)) = a3; }
}
__device__ __forceinline__ void transpose_tile(const float* W, int K, int N, bf16* WT, int k0, int n0, int drow0, LAS float* scr, int lane) {
#pragma unroll 8
    for (int i = 0; i < 32; ++i) { const int kk = 2 * i + (lane >> 5); scr[kk * 33 + (lane & 31)] = W[(size_t)(k0 + kk) * N + n0 + (lane & 31)]; }
    LDS_WAIT(); asm volatile("" ::: "memory");
    const int c = lane & 7;
#pragma unroll
    for (int j = 0; j < 4; ++j) { const int n = (lane >> 3) + 8 * j; const LAS float* s = scr + (8 * c) * 33 + n;
        u32x4 o; o.x = pk2(s[0 * 33], s[1 * 33]); o.y = pk2(s[2 * 33], s[3 * 33]); o.z = pk2(s[4 * 33], s[5 * 33]); o.w = pk2(s[6 * 33], s[7 * 33]);
        *(GAS u32x4*)(WT + (size_t)(drow0 + n) * K + k0 + 8 * c) = o; }
    LDS_WAIT(); asm volatile("" ::: "memory");
}
enum MapKind { MAP_ID = 0, MAP_FFI = 1, MAP_DKV = 2, MAP_UQ = 3 };
__device__ __forceinline__ int map_row(int kind, int n0) {
    if (kind == MAP_FFI) { const int half = n0 >= FF ? 1 : 0, j = n0 - half * FF; return 256 * (j >> 7) + 128 * half + (j & 127); }
    if (kind == MAP_DKV) { return n0 < 544 ? n0 : 640 + (n0 - 544); }
    if (kind == MAP_UQ) { const int head = n0 / 192, d = n0 % 192; if (d < 128) return (head >> 1) * 256 + (head & 1) * 128 + d;
        const int i = d - 128; return 2048 + (head >> 2) * 256 + (i >> 5) * 128 + (head & 3) * 32 + (i & 31); }
    return n0;
}
__device__ __forceinline__ void cvt_item(const float* W, int K, int N, bf16* WT, int kind, int r, LAS float* scr, int lane) {
    const int nblk = N / 32, kb = r / nblk, nb = r % nblk;
    transpose_tile(W, K, N, WT, 64 * kb, 32 * nb, map_row(kind, 32 * nb), scr, lane);
}
__device__ __forceinline__ void sincos_acc(float ang, float& c, float& s) {
    const double x = (double)ang; const double n = __builtin_rint(x * 0.63661977236758134308);
    double r = __builtin_fma(-n, 1.57079632679489655800, x); r = __builtin_fma(-n, 6.12323399573676603587e-17, r);
    const double r2 = r * r;
    double sp = 1.0 / 6227020800.0; sp = sp * r2 - 1.0 / 39916800.0; sp = sp * r2 + 1.0 / 362880.0; sp = sp * r2 - 1.0 / 5040.0; sp = sp * r2 + 1.0 / 120.0; sp = sp * r2 - 1.0 / 6.0; sp = sp * r2 + 1.0; sp *= r;
    double cp = -1.0 / 87178291200.0; cp = cp * r2 + 1.0 / 479001600.0; cp = cp * r2 - 1.0 / 3628800.0; cp = cp * r2 + 1.0 / 40320.0; cp = cp * r2 - 1.0 / 720.0; cp = cp * r2 + 1.0 / 24.0; cp = cp * r2 - 0.5; cp = cp * r2 + 1.0;
    const int q = ((int)n) & 3;
    const double cc = (q == 0) ? cp : (q == 1) ? -sp : (q == 2) ? -cp : sp;
    const double ss = (q == 0) ? sp : (q == 1) ? cp : (q == 2) ? -sp : -cp;
    c = (float)cc; s = (float)ss;
}

__device__ __forceinline__ void norm_phase(const Ctx& C, const float* X, const float* g, const float* shift, const float* scale, int bstride, bf16* H) {
    const int gw = C.vcu * 8 + C.wave, NGW = C.G * 8;
    for (int m0 = gw * 8; m0 < M; m0 += NGW * 8) {
        const int b = m0 >> 12;
        f32x4 gs[8], sh[8];
#pragma unroll
        for (int j = 0; j < 8; ++j) { const int c = 4 * C.lane + 256 * j; const f32x4 gg = *(const f32x4*)(g + c), sc = *(const f32x4*)(scale + (size_t)b * bstride + c);
            gs[j] = gg * (sc + 1.0f); sh[j] = *(const f32x4*)(shift + (size_t)b * bstride + c); }
        for (int r = 0; r < 8; ++r) {
            const GAS f32x4* xr = (const GAS f32x4*)(X + (size_t)(m0 + r) * D) + C.lane;
            f32x4 v[8]; float s = 0.f;
#pragma unroll
            for (int j = 0; j < 8; ++j) { v[j] = xr[64 * j]; s += (v[j].x * v[j].x + v[j].y * v[j].y) + (v[j].z * v[j].z + v[j].w * v[j].w); }
            const float rstd = __builtin_amdgcn_rsqf(wave_sum(s) * (1.0f / D) + EPS);
            GAS u32x2* o8 = (GAS u32x2*)(H + (size_t)(m0 + r) * D) + C.lane;
#pragma unroll
            for (int j = 0; j < 8; ++j) { const f32x4 y = v[j] * rstd * gs[j] + sh[j]; u32x2 w; w.x = pk2(y.x, y.y); w.y = pk2(y.z, y.w); o8[64 * j] = w; }
        }
    }
}
__device__ __forceinline__ void norm2_phase(const Ctx& C, const float* X, const float* g1, const float* shift1, const float* scale1, int bstride1, bf16* H1,
                                            const float* g2, const float* shift2, const float* scale2, int bstride2, bf16* H2) {
    const int gw = C.vcu * 8 + C.wave, NGW = C.G * 8;
    for (int m0 = gw * 8; m0 < M; m0 += NGW * 8) {
        const int b = m0 >> 12;
        f32x4 gs1[8], sh1[8], gs2[8], sh2[8];
#pragma unroll
        for (int j = 0; j < 8; ++j) { const int c = 4 * C.lane + 256 * j;
            gs1[j] = *(const f32x4*)(g1 + c) * (*(const f32x4*)(scale1 + (size_t)b * bstride1 + c) + 1.0f); sh1[j] = *(const f32x4*)(shift1 + (size_t)b * bstride1 + c);
            gs2[j] = *(const f32x4*)(g2 + c) * (*(const f32x4*)(scale2 + (size_t)b * bstride2 + c) + 1.0f); sh2[j] = *(const f32x4*)(shift2 + (size_t)b * bstride2 + c); }
#pragma unroll 1
        for (int r = 0; r < 8; ++r) {
            const GAS f32x4* xr = (const GAS f32x4*)(X + (size_t)(m0 + r) * D) + C.lane;
            f32x4 v[8]; float s = 0.f;
#pragma unroll
            for (int j = 0; j < 8; ++j) { v[j] = xr[64 * j]; s += (v[j].x * v[j].x + v[j].y * v[j].y) + (v[j].z * v[j].z + v[j].w * v[j].w); }
            const float rstd = __builtin_amdgcn_rsqf(wave_sum(s) * (1.0f / D) + EPS);
            GAS u32x2* o1 = (GAS u32x2*)(H1 + (size_t)(m0 + r) * D) + C.lane; GAS u32x2* o2 = (GAS u32x2*)(H2 + (size_t)(m0 + r) * D) + C.lane;
#pragma unroll
            for (int j = 0; j < 8; ++j) { const f32x4 xn = v[j] * rstd; const f32x4 y1 = xn * gs1[j] + sh1[j], y2 = xn * gs2[j] + sh2[j];
                u32x2 w1, w2; w1.x = pk2(y1.x, y1.y); w1.y = pk2(y1.z, y1.w); w2.x = pk2(y2.x, y2.y); w2.y = pk2(y2.z, y2.w); o1[64 * j] = w1; o2[64 * j] = w2; }
        }
    }
}
__device__ __forceinline__ void final_norm_phase(const Ctx& C, float* X, const float* g) {
    const int gw = C.vcu * 8 + C.wave, NGW = C.G * 8;
    f32x4 gs[8];
#pragma unroll
    for (int j = 0; j < 8; ++j) gs[j] = *(const f32x4*)(g + 4 * C.lane + 256 * j);
    for (int m = gw; m < M; m += NGW) {
        GAS f32x4* xr = (GAS f32x4*)(X + (size_t)m * D) + C.lane;
        f32x4 v[8]; float s = 0.f;
#pragma unroll
        for (int j = 0; j < 8; ++j) { v[j] = xr[64 * j]; s += (v[j].x * v[j].x + v[j].y * v[j].y) + (v[j].z * v[j].z + v[j].w * v[j].w); }
        const float rstd = __builtin_amdgcn_rsqf(wave_sum(s) * (1.0f / D) + EPS);
#pragma unroll
        for (int j = 0; j < 8; ++j) xr[64 * j] = v[j] * rstd * gs[j];
    }
}

namespace ret {
constexpr int PQ = 528, PV = 272;
constexpr int QI = 0, KI = 64 * PQ, ST = 2 * 64 * PQ, VI = 3 * 64 * PQ, RED = VI + 64 * PV, RET_LDS = RED + 16384;
static_assert(RET_LDS <= RING_BYTES, "retention LDS");
__device__ __forceinline__ s16x4 trd(const LAS unsigned char* p) { return __builtin_bit_cast(s16x4, __builtin_amdgcn_ds_read_tr16_b64_v4i16((LAS v4i16_t*)p)); }
__device__ __forceinline__ bf16x8 cat(s16x4 lo, s16x4 hi) { return (bf16x8){lo[0], lo[1], lo[2], lo[3], hi[0], hi[1], hi[2], hi[3]}; }
#define MFMA16(a, b, c) __builtin_amdgcn_mfma_f32_16x16x32_bf16((a), (b), (c), 0, 0, 0)

__device__ __forceinline__ void retention_phase(const Ctx& C, const bf16* RQ, const bf16* RK, const bf16* RV, bf16* RO, float* RSTAT) {
    LAS unsigned char* lds = C.lds;
    const int tid = C.tid, lane = C.lane, w = C.wave, l15 = lane & 15, quad = lane >> 4, q4 = (lane & 15) >> 2, p4 = lane & 3;
    const int ci = w & 3, rh = w >> 2;
    const LAS unsigned char* bQ  = lds + QI + (16 * ci + l15) * PQ + quad * 16;
    const LAS unsigned char* bK  = lds + KI + (32 * rh + l15) * PQ + quad * 16;
    const LAS unsigned char* bS  = lds + ST + l15 * PQ + quad * 16;
    const LAS unsigned char* bV1 = lds + VI + (32 * rh + 4 * quad + q4) * PV + p4 * 8;
    const LAS unsigned char* bK2 = lds + KI + (8 * quad + q4) * PQ + (32 * w + 4 * p4) * 2;
    const LAS unsigned char* bV2 = lds + VI + (8 * quad + q4) * PV + p4 * 8 + 128;
    LAS unsigned char* bSW = lds + ST + l15 * PQ + (32 * w + 4 * quad) * 2;
    LAS unsigned char* bR  = lds + RED + ci * 4096 + lane * 4;
    LAS unsigned char* bSt = lds + (tid >> 5) * PQ + (tid & 31) * 16;
    const int vrow = tid >> 3, vch = tid & 7;
    LAS unsigned char* bVs = lds + VI + vrow * PV + vch * 16;
    for (int unit = C.vcu; unit < 256; unit += C.G) {
        const int b = unit >> 6, h = (unit >> 3) & 7, vs = unit & 7;
        const float log2g = __builtin_log2f(1.0f - __builtin_exp2f(-5.0f - (float)h));
        const float gchunk = __builtin_exp2f(log2g * 64.0f);
        float fdec[2][4];
        const int iq = 16 * ci + l15;
#pragma unroll
        for (int jt = 0; jt < 2; ++jt)
#pragma unroll
            for (int e = 0; e < 4; ++e) { const int j = 32 * rh + 16 * jt + 4 * quad + e; const int d = (iq > j ? iq - j : j - iq) - (iq + 1); fdec[jt][e] = __builtin_exp2f(log2g * (float)d); }
        const float xi = __builtin_exp2f(log2g * (float)(iq + 1));
        const float zeta = __builtin_exp2f(log2g * (float)(63 - vrow));
        __syncthreads();
        for (int i = tid; i < 64 * PQ / 16; i += 512) *(LAS u32x4*)(lds + ST + i * 16) = (u32x4){0u, 0u, 0u, 0u};
        f32x4 st[2][4];
#pragma unroll
        for (int mt = 0; mt < 2; ++mt)
#pragma unroll
            for (int nt = 0; nt < 4; ++nt) st[mt][nt] = (f32x4){0.f, 0.f, 0.f, 0.f};
        const size_t tok0 = (size_t)b * SEQ;
        const bf16* qg = RQ + (tok0 + (tid >> 5)) * D + h * 256 + (tid & 31) * 8; const bf16* kg = RK + (tok0 + (tid >> 5)) * D + h * 256 + (tid & 31) * 8;
        const bf16* vg = RV + (tok0 + vrow) * 4096 + h * 512 + vs * 64 + vch * 8;
        u32x4 qreg[4], kreg[4], vreg;
#define RET_LOAD(c) do { const size_t t0_ = (size_t)(c) * 64; _Pragma("unroll") for (int i = 0; i < 4; ++i) { \
            qreg[i] = *(const GAS u32x4*)(qg + (t0_ + 16 * i) * D); kreg[i] = *(const GAS u32x4*)(kg + (t0_ + 16 * i) * D); } \
            vreg = *(const GAS u32x4*)(vg + t0_ * 4096); } while (0)
#define RET_STORE() do { _Pragma("unroll") for (int i = 0; i < 4; ++i) { *(LAS u32x4*)(bSt + QI + 16 * i * PQ) = qreg[i]; *(LAS u32x4*)(bSt + KI + 16 * i * PQ) = kreg[i]; } \
            *(LAS u32x4*)(bVs) = vreg; \
            u32x4 vz; vz.x = pk2(bf_lo(vreg.x) * zeta, bf_hi(vreg.x) * zeta); vz.y = pk2(bf_lo(vreg.y) * zeta, bf_hi(vreg.y) * zeta); vz.z = pk2(bf_lo(vreg.z) * zeta, bf_hi(vreg.z) * zeta); vz.w = pk2(bf_lo(vreg.w) * zeta, bf_hi(vreg.w) * zeta); \
            *(LAS u32x4*)(bVs + 128) = vz; } while (0)
        RET_LOAD(0);
        RET_STORE();
        RET_LOAD(1);
#pragma unroll 1
        for (int c = 0; c < 64; ++c) {
            __syncthreads();
            f32x4 sT[2] = {(f32x4){0.f, 0.f, 0.f, 0.f}, (f32x4){0.f, 0.f, 0.f, 0.f}};
            f32x4 acc[4];
#pragma unroll
            for (int t = 0; t < 4; ++t) acc[t] = (f32x4){0.f, 0.f, 0.f, 0.f};
#pragma unroll
            for (int s = 0; s < 8; ++s) {
                const bf16x8 qf = *(const LAS bf16x8*)(bQ + 64 * s);
#pragma unroll
                for (int jt = 0; jt < 2; ++jt) { const bf16x8 kf = *(const LAS bf16x8*)(bK + 16 * jt * PQ + 64 * s); sT[jt] = MFMA16(kf, qf, sT[jt]); }
                if ((s >> 2) == rh) {
#pragma unroll
                    for (int t = 0; t < 4; ++t) { const bf16x8 sf = *(const LAS bf16x8*)(bS + 16 * t * PQ + 64 * s); acc[t] = MFMA16(sf, qf, acc[t]); }
                }
            }
            u32x4 pw; pw.x = pk2(sT[0][0] * fdec[0][0], sT[0][1] * fdec[0][1]); pw.y = pk2(sT[0][2] * fdec[0][2], sT[0][3] * fdec[0][3]);
            pw.z = pk2(sT[1][0] * fdec[1][0], sT[1][1] * fdec[1][1]); pw.w = pk2(sT[1][2] * fdec[1][2], sT[1][3] * fdec[1][3]);
            const bf16x8 pf = __builtin_bit_cast(bf16x8, pw);
#pragma unroll
            for (int t = 0; t < 4; ++t) {
                const s16x4 lo = trd(bV1 + 32 * t), hi = trd(bV1 + 16 * PV + 32 * t);
                acc[t] = MFMA16(cat(lo, hi), pf, acc[t]);
            }
#pragma unroll
            for (int mt = 0; mt < 2; ++mt)
#pragma unroll
                for (int nt = 0; nt < 4; ++nt) st[mt][nt] *= gchunk;
#pragma unroll
            for (int ks = 0; ks < 2; ++ks) {
                bf16x8 af[2], bfv[4];
#pragma unroll
                for (int mt = 0; mt < 2; ++mt) af[mt] = cat(trd(bK2 + (32 * ks) * PQ + 32 * mt), trd(bK2 + (32 * ks + 4) * PQ + 32 * mt));
#pragma unroll
                for (int nt = 0; nt < 4; ++nt) bfv[nt] = cat(trd(bV2 + (32 * ks) * PV + 32 * nt), trd(bV2 + (32 * ks + 4) * PV + 32 * nt));
#pragma unroll
                for (int mt = 0; mt < 2; ++mt)
#pragma unroll
                    for (int nt = 0; nt < 4; ++nt) st[mt][nt] = MFMA16(af[mt], bfv[nt], st[mt][nt]);
            }
            if (rh == 1) {
#pragma unroll
                for (int t = 0; t < 4; ++t)
#pragma unroll
                    for (int e = 0; e < 4; ++e) *(LAS float*)(bR + (t * 4 + e) * 256) = acc[t][e];
            }
            __syncthreads();
            if (rh == 0) {
                float s1 = 0.f, s2 = 0.f;
                bf16* op = RO + (tok0 + (size_t)c * 64 + iq) * 4096 + h * 512 + vs * 64 + 4 * quad;
#pragma unroll
                for (int t = 0; t < 4; ++t) { f32x4 o;
#pragma unroll
                    for (int e = 0; e < 4; ++e) { o[e] = (acc[t][e] + *(const LAS float*)(bR + (t * 4 + e) * 256)) * xi; s1 += o[e]; s2 += o[e] * o[e]; }
                    u32x2 wv; wv.x = pk2(o[0], o[1]); wv.y = pk2(o[2], o[3]); *(GAS u32x2*)(op + 16 * t) = wv; }
                s1 += __shfl_xor(s1, 16); s1 += __shfl_xor(s1, 32); s2 += __shfl_xor(s2, 16); s2 += __shfl_xor(s2, 32);
                if (quad == 0) *(GAS f32x2*)(RSTAT + (((tok0 + (size_t)c * 64 + iq) * 8 + h) * 8 + vs) * 2) = (f32x2){s1, s2};
            }
#pragma unroll
            for (int mt = 0; mt < 2; ++mt)
#pragma unroll
                for (int nt = 0; nt < 4; ++nt) { u32x2 wv; wv.x = pk2(st[mt][nt][0], st[mt][nt][1]); wv.y = pk2(st[mt][nt][2], st[mt][nt][3]); *(LAS u32x2*)(bSW + 16 * nt * PQ + 32 * mt) = wv; }
            if (c + 1 < 64) { RET_STORE(); if (c + 2 < 64) RET_LOAD(c + 2); }
        }
#undef RET_LOAD
#undef RET_STORE
    }
    __syncthreads();
}
__device__ __forceinline__ void gate_phase(const Ctx& C, const bf16* RO, bf16* RG, const float* RSTAT, const float* gn_g) {
    const int gw = C.vcu * 8 + C.wave, NGW = C.G * 8;
    for (int m = gw; m < M; m += NGW) {
#pragma unroll
        for (int k = 0; k < 8; ++k) {
            const float* sp = RSTAT + ((size_t)m * 8 + k) * 16; float s1 = 0.f, s2 = 0.f;
#pragma unroll
            for (int j = 0; j < 4; ++j) { const f32x4 v = *(const f32x4*)(sp + 4 * j); s1 += v[0] + v[2]; s2 += v[1] + v[3]; }
            const float mu = s1 * (1.0f / 512.0f), var = s2 * (1.0f / 512.0f) - mu * mu, rstd = __builtin_amdgcn_rsqf(var + EPS);
            const size_t off = (size_t)m * 4096 + 8 * (C.lane + 64 * k);
            const u32x4 ov = *(const GAS u32x4*)(RO + off), gv = *(const GAS u32x4*)(RG + off);
            const f32x4 g0 = *(const f32x4*)(gn_g + 8 * (C.lane + 64 * k)), g1 = *(const f32x4*)(gn_g + 8 * (C.lane + 64 * k) + 4);
            u32x4 r;
            r.x = pk2(bf_lo(gv.x) * (bf_lo(ov.x) - mu) * rstd * g0[0], bf_hi(gv.x) * (bf_hi(ov.x) - mu) * rstd * g0[1]);
            r.y = pk2(bf_lo(gv.y) * (bf_lo(ov.y) - mu) * rstd * g0[2], bf_hi(gv.y) * (bf_hi(ov.y) - mu) * rstd * g0[3]);
            r.z = pk2(bf_lo(gv.z) * (bf_lo(ov.z) - mu) * rstd * g1[0], bf_hi(gv.z) * (bf_hi(ov.z) - mu) * rstd * g1[1]);
            r.w = pk2(bf_lo(gv.w) * (bf_lo(ov.w) - mu) * rstd * g1[2], bf_hi(gv.w) * (bf_hi(ov.w) - mu) * rstd * g1[3]);
            *(GAS u32x4*)(RG + off) = r;
        }
    }
}
}

namespace att {
constexpr int KSTG = 24576, VSTG = 16384, VRING = 3 * KSTG, ATT_LDS = VRING + 4 * VSTG;
static_assert(ATT_LDS <= RING_BYTES, "attention LDS");
using ret::cat;
#define MFMA32(a, b, c) __builtin_amdgcn_mfma_f32_32x32x16_bf16((a), (b), (c), 0, 0, 0)
#define MK_APROBE_WAVE 0
#ifndef MK_APROBE
#define MK_APROBE 0
#endif
#define ATT_T0(id) unsigned long long pt0_ = 0ull; if (MK_APROBE == (id)) { asm volatile("s_memrealtime %0\n\ts_waitcnt lgkmcnt(0)" : "=s"(pt0_) :: "memory"); }
#define ATT_T1(id) if (MK_APROBE == (id)) { unsigned long long pt1_; asm volatile("s_memrealtime %0\n\ts_waitcnt lgkmcnt(0)" : "=s"(pt1_) :: "memory"); aprobe += pt1_ - pt0_; }
#define ATT_WAITL(n) do { switch (n) { case 0: asm volatile("s_waitcnt lgkmcnt(0)" ::: "memory"); break; case 2: asm volatile("s_waitcnt lgkmcnt(2)" ::: "memory"); break; case 4: asm volatile("s_waitcnt lgkmcnt(4)" ::: "memory"); break; \
    case 6: asm volatile("s_waitcnt lgkmcnt(6)" ::: "memory"); break; case 8: asm volatile("s_waitcnt lgkmcnt(8)" ::: "memory"); break; default: asm volatile("s_waitcnt lgkmcnt(10)" ::: "memory"); break; } } while (0)
#define ATT_BAR() do { __builtin_amdgcn_s_barrier(); asm volatile("" ::: "memory"); } while (0)

__device__ __forceinline__ void attention_phase(const Ctx& C, const bf16* QQ, const bf16* KN, const bf16* KR, const bf16* VV, bf16* AO) {
    LAS unsigned char* lds = C.lds;
    const int lane = C.lane, w = C.wave, r32 = lane & 31, hi = lane >> 5, grp = w >> 2;
    unsigned long long aprobe = 0ull;
    const int dk8 = lane >> 3, dp = lane & 7;
    const unsigned q8a = (unsigned)((dp ^ (dk8 >> 1)) * 8), q8b = (unsigned)((dp ^ ((dk8 >> 1) | 4)) * 8);
    const unsigned kn_off0 = (unsigned)dk8 * 2048u + q8a, kn_off1 = (unsigned)dk8 * 2048u + q8b, kr_off0 = (unsigned)dk8 * 64u + q8a, kr_off1 = (unsigned)dk8 * 64u + q8b;
    const unsigned vq_off = (unsigned)dk8 * 2048u + (unsigned)((dp ^ (((dk8 >> 1) & 1) << 2)) * 8);
    const unsigned q_off = (unsigned)r32 * 3072u + 8u * hi, o_off = (unsigned)r32 * 2048u + 4u * hi;
    const int fk8 = r32 & 7, foct = r32 >> 3, ff = (fk8 >> 1) | ((foct >> 1) << 2);
    const unsigned krd = (unsigned)(foct * 1024 + fk8 * 128);
    const int q4 = (lane & 15) >> 2, p4 = lane & 3, blk = (lane >> 4) & 1, vk8 = 4 * hi + q4, vf = ((vk8 >> 1) & 1) << 2;
    const unsigned vrd = (unsigned)(vk8 * 128 + 8 * (p4 & 1));
    unsigned vqo[2];
#pragma unroll
    for (int c1 = 0; c1 < 2; ++c1) vqo[c1] = vrd + (unsigned)(((4 * c1 + 2 * blk + (p4 >> 1)) ^ vf) * 16);
    for (int pair = C.vcu; pair < 512; pair += C.G) {
#pragma unroll 1
        for (int half = 0; half < 2; ++half) {
            const int bh = pair >> 3, pr = pair & 7, qb = half ? 15 - pr : pr, b = bh >> 4, h = bh & 15;
            const size_t tok0 = (size_t)b * SEQ;
            const int NT = 4 * qb + 4, myc = 4 * qb + (w >> 1);
            asm volatile("s_waitcnt vmcnt(0)" ::: "memory"); ATT_BAR();
            const bf16* knb = KN + tok0 * 2048 + h * 128; const bf16* krb = KR + tok0 * 64; const bf16* vvb = VV + tok0 * 2048 + h * 128;
#define ATT_DMA(t, kst, vst) do { \
                _Pragma("unroll") for (int i = 0; i < 3; ++i) { const int j = 3 * w + i, kk = j / 12, g = (j % 12) >> 2, oct = j & 3; const size_t key0 = (size_t)(t) * 64 + 32 * kk + 8 * oct; \
                    const bf16* ub = g < 2 ? knb + key0 * 2048 + g * 64 : krb + key0 * 64; const unsigned lo = g < 2 ? ((oct >> 1) ? kn_off1 : kn_off0) : ((oct >> 1) ? kr_off1 : kr_off0); const bf16* src = ub + lo; \
                    __builtin_amdgcn_global_load_lds((const unsigned*)src, (LAS unsigned*)(lds + (kst) * KSTG + j * 1024), 16, 0, 0); } \
                _Pragma("unroll") for (int i = 0; i < 2; ++i) { const int j = 2 * w + i, oct8 = j >> 1, dvh = j & 1; \
                    const bf16* src = vvb + ((size_t)(t) * 64 + 8 * oct8) * 2048 + dvh * 64 + vq_off; \
                    __builtin_amdgcn_global_load_lds((const unsigned*)src, (LAS unsigned*)(lds + VRING + (vst) * VSTG + j * 1024), 16, 0, 0); } } while (0)
            ATT_DMA(0, 0, 0); ATT_DMA(1, 1, 1);
            asm volatile("" ::: "memory");
            bf16x8 qf[12];
            { const bf16* qp = QQ + (tok0 + (size_t)qb * 256 + w * 32) * 3072 + h * 192;
#pragma unroll
              for (int s = 0; s < 12; ++s) qf[s] = *(const GAS bf16x8*)(qp + 16 * s + q_off); }
            f32x16 o[4];
#pragma unroll
            for (int c = 0; c < 4; ++c)
#pragma unroll
                for (int r = 0; r < 16; ++r) o[c][r] = 0.f;
            float mrun = 0.f, lsum = 0.f;
            if (grp == 1) { asm volatile("s_waitcnt vmcnt(5)" ::: "memory"); ATT_BAR(); }
            int kst = 0, vst = 0;
#pragma unroll 1
            for (int t = 0; t < NT; ++t) {
                f32x16 s0, s1;
                { ATT_T0(1) if (grp == 0) { if (t + 1 < NT) asm volatile("s_waitcnt vmcnt(5)" ::: "memory"); else asm volatile("s_waitcnt vmcnt(0)" ::: "memory"); }
                  ATT_BAR(); ATT_T1(1) }
                if (t <= myc) { ATT_T0(2)
                    const unsigned kbase = (unsigned)(size_t)(lds + kst * KSTG) + krd;
                    u32x4 k0b[3], k1b[3];
#define ATT_KRD(buf, s) do { const unsigned ka_ = kbase + (unsigned)((((2 * ((s) & 3) + hi) ^ ff) * 16)); \
                        asm volatile("ds_read_b128 %0, %2 offset:%c3\n\tds_read_b128 %1, %2 offset:%c4" : "=&v"(k0b[buf]), "=&v"(k1b[buf]) : "v"(ka_), "i"(((s) >> 2) * 4096), "i"((3 + ((s) >> 2)) * 4096) : "memory"); } while (0)
                    ATT_KRD(0, 0); ATT_KRD(1, 1);
                    { const float nm_ = -mrun;
#pragma unroll
                      for (int r = 0; r < 16; ++r) { s0[r] = nm_; s1[r] = nm_; } }
#pragma unroll
                    for (int s = 0; s < 12; ++s) {
                        if (s + 2 < 12) ATT_KRD((s + 2) % 3, s + 2);
                        ATT_WAITL(2 * ((11 - s) < 2 ? (11 - s) : 2));
                        __builtin_amdgcn_sched_barrier(0);
                        s0 = MFMA32(__builtin_bit_cast(bf16x8, k0b[s % 3]), qf[s], s0); s1 = MFMA32(__builtin_bit_cast(bf16x8, k1b[s % 3]), qf[s], s1);
                        __builtin_amdgcn_sched_barrier(0); }
                    ATT_T1(2) }
                { ATT_T0(4) if (t + 2 < NT) { const int k2 = kst == 0 ? 2 : kst - 1, v2 = (vst + 2) & 3; ATT_DMA(t + 2, k2, v2); } ATT_T1(4) }
                { ATT_T0(3) if (grp == 1) { if (t + 2 < NT) asm volatile("s_waitcnt vmcnt(5)" ::: "memory"); else asm volatile("s_waitcnt vmcnt(0)" ::: "memory"); }
                  ATT_BAR(); ATT_T1(3) }
                if (t <= myc) { ATT_T0(5)
                    float mx = __builtin_fmaxf(s0[0], s1[0]);
#pragma unroll
                    for (int r = 1; r < 16; ++r) mx = __builtin_fmaxf(mx, __builtin_fmaxf(s0[r], s1[r]));
                    { auto rr_ = __builtin_amdgcn_permlane32_swap(__float_as_uint(mx), __float_as_uint(mx), false, false); mx = __builtin_fmaxf(__uint_as_float(rr_[0]), __uint_as_float(rr_[1])); }
                    if (t == 0 || __any(mx > 8.0f)) {
                        const float d = t == 0 ? mx : __builtin_fmaxf(mx, 0.f), alpha = __builtin_amdgcn_exp2f(-d); mrun += d; lsum *= alpha;
#pragma unroll
                        for (int r = 0; r < 16; ++r) { s0[r] -= d; s1[r] -= d; }
#pragma unroll
                        for (int c = 0; c < 4; ++c)
#pragma unroll
                            for (int r = 0; r < 16; ++r) o[c][r] *= alpha;
                    }
                    float ps = 0.f;
#pragma unroll
                    for (int r = 0; r < 16; ++r) { s0[r] = __builtin_amdgcn_exp2f(s0[r]); s1[r] = __builtin_amdgcn_exp2f(s1[r]); ps += s0[r] + s1[r]; }
                    lsum += ps;
                    bf16x8 pf[4];
                    { u32x4 a; a.x = pk2(s0[0], s0[1]); a.y = pk2(s0[2], s0[3]); a.z = pk2(s0[4], s0[5]); a.w = pk2(s0[6], s0[7]); pf[0] = __builtin_bit_cast(bf16x8, a);
                      a.x = pk2(s0[8], s0[9]); a.y = pk2(s0[10], s0[11]); a.z = pk2(s0[12], s0[13]); a.w = pk2(s0[14], s0[15]); pf[1] = __builtin_bit_cast(bf16x8, a);
                      a.x = pk2(s1[0], s1[1]); a.y = pk2(s1[2], s1[3]); a.z = pk2(s1[4], s1[5]); a.w = pk2(s1[6], s1[7]); pf[2] = __builtin_bit_cast(bf16x8, a);
                      a.x = pk2(s1[8], s1[9]); a.y = pk2(s1[10], s1[11]); a.z = pk2(s1[12], s1[13]); a.w = pk2(s1[14], s1[15]); pf[3] = __builtin_bit_cast(bf16x8, a); }
                    const unsigned vb0 = (unsigned)(size_t)(lds + VRING + vst * VSTG) + vqo[0], vb1 = (unsigned)(size_t)(lds + VRING + vst * VSTG) + vqo[1];
                    s16x4 vl[4], vh[4];
#define ATT_VRD(buf, ix) do { if (((ix) & 1) == 0) asm volatile("ds_read_b64_tr_b16 %0, %2 offset:%c3\n\tds_read_b64_tr_b16 %1, %2 offset:%c4" : "=&v"(vl[buf]), "=&v"(vh[buf]) : "v"(vb0), "i"(((ix) >> 2) * 4096 + (((ix) >> 1) & 1) * 1024), "i"(((ix) >> 2) * 4096 + 2048 + (((ix) >> 1) & 1) * 1024) : "memory"); \
                        else asm volatile("ds_read_b64_tr_b16 %0, %2 offset:%c3\n\tds_read_b64_tr_b16 %1, %2 offset:%c4" : "=&v"(vl[buf]), "=&v"(vh[buf]) : "v"(vb1), "i"(((ix) >> 2) * 4096 + (((ix) >> 1) & 1) * 1024), "i"(((ix) >> 2) * 4096 + 2048 + (((ix) >> 1) & 1) * 1024) : "memory"); } while (0)
                    ATT_VRD(0, 0); ATT_VRD(1, 1); ATT_VRD(2, 2);
#pragma unroll
                    for (int ix = 0; ix < 16; ++ix) {
                        if (ix + 3 < 16) ATT_VRD((ix + 3) & 3, ix + 3);
                        ATT_WAITL(2 * ((15 - ix) < 3 ? (15 - ix) : 3));
                        __builtin_amdgcn_sched_barrier(0);
                        o[ix & 3] = MFMA32(cat(vl[ix & 3], vh[ix & 3]), pf[ix >> 2], o[ix & 3]);
                        __builtin_amdgcn_sched_barrier(0); }
                    ATT_T1(5) }
                kst = kst == 2 ? 0 : kst + 1; vst = (vst + 1) & 3;
            }
            if (grp == 0) ATT_BAR();
            const float linv = 1.0f / (lsum + __shfl_xor(lsum, 32));
            bf16* op = AO + (tok0 + (size_t)qb * 256 + w * 32) * 2048 + h * 128;
#pragma unroll
            for (int c = 0; c < 4; ++c)
#pragma unroll
                for (int g4 = 0; g4 < 4; ++g4) { u32x2 wv; wv.x = pk2(o[c][4 * g4] * linv, o[c][4 * g4 + 1] * linv); wv.y = pk2(o[c][4 * g4 + 2] * linv, o[c][4 * g4 + 3] * linv);
                    *(GAS u32x2*)(op + 32 * c + 8 * g4 + o_off) = wv; }
#undef ATT_DMA
#undef ATT_KRD
#undef ATT_VRD
#undef ATT_KADDR
        }
    }
    asm volatile("s_waitcnt vmcnt(0)" ::: "memory");
    __syncthreads();
    if (MK_APROBE != 0 && C.tid == MK_APROBE_WAVE * 64 && (int)blockIdx.x == MK_KPROBE_BLK) *(volatile LAS unsigned*)(lds + MISC_OFF + 60) = (unsigned)aprobe;
}
}

struct Args { const float* in[22]; float* out; unsigned char* ws; int ph_lo, ph_hi; };
typedef const __attribute__((address_space(4))) Args* ArgsP;
__device__ __forceinline__ ArgsP argp() { ArgsP p_ = (ArgsP)__builtin_amdgcn_kernarg_segment_ptr(); asm volatile("" : "+s"(p_)); return p_; }
#define ARG_IN(k) (argp()->in[k])
enum { I_X = 0, I_C, I_POS, I_ADAW, I_ADAB, I_NORMG, I_FFI, I_FFO, I_RWI, I_RGN, I_RWO, I_KVAW, I_KVAB, I_KVNG, I_WDKV, I_KVLG, I_WUKV, I_WDQ, I_QLG, I_WUQ, I_WMO, I_FING };
constexpr int N_PHASES = 28;
__device__ __forceinline__ void prologue_phase(const Ctx& C, float* MODSP, bf16* WFI, bf16* WFO, bf16* WRI, bf16* WRO, bf16* WDKV, bf16* WUKV, bf16* WDQ, bf16* WUQ, bf16* WMO,
                                               float* COSR, float* SINR, float* COSM, float* SINM) {
    __syncthreads();
        { const float* c = ARG_IN(I_C); LAS float* cact = (LAS float*)C.lds; for (int i = C.tid; i < 4 * D; i += 512) cact[i] = silu_f(c[i]); }
        __syncthreads();
        const int gw = C.vcu * 8 + C.wave, NGW = C.G * 8;
        constexpr int N_MODS_ITEMS = (NCOLS_MODS / 32) * 8;
        for (int it = gw; it < N_MODS_ITEMS; it += NGW) mods_item(C, it, ARG_IN(I_ADAW), ARG_IN(I_KVAW), MODSP);
        LAS float* scr = (LAS float*)(C.lds + 32768 + C.wave * 8448);
        constexpr int I_FI = (D / 64) * (2 * FF / 32), I_FO = (FF / 64) * (D / 32), I_RI = (D / 64) * (RIN / 32), I_RO = (4096 / 64) * (D / 32), I_DKV = (D / 64) * (576 / 32),
                      I_UKV = (512 / 64) * (4096 / 32), I_DQ = (D / 64) * (512 / 32), I_UQ = (512 / 64) * (3072 / 32), I_MO = (D / 64) * (D / 32);
        constexpr int NITEMS = 4 * I_FI + 4 * I_FO + I_RI + I_RO + I_DKV + I_UKV + I_DQ + I_UQ + I_MO;
        for (int it = gw; it < NITEMS; it += NGW) {
            int r = it;
            if (r < 4 * I_FI) { const int q = r / I_FI; cvt_item(ARG_IN(I_FFI) + (size_t)q * D * 2 * FF, D, 2 * FF, WFI + (size_t)q * WFI_ELEMS, MAP_FFI, r % I_FI, scr, C.lane); continue; } r -= 4 * I_FI;
            if (r < 4 * I_FO) { const int q = r / I_FO; cvt_item(ARG_IN(I_FFO) + (size_t)q * FF * D, FF, D, WFO + (size_t)q * WFO_ELEMS, MAP_ID, r % I_FO, scr, C.lane); continue; } r -= 4 * I_FO;
            if (r < I_RI) { cvt_item(ARG_IN(I_RWI), D, RIN, WRI, MAP_ID, r, scr, C.lane); continue; } r -= I_RI;
            if (r < I_RO) { cvt_item(ARG_IN(I_RWO), 4096, D, WRO, MAP_ID, r, scr, C.lane); continue; } r -= I_RO;
            if (r < I_DKV) { cvt_item(ARG_IN(I_WDKV), D, 576, WDKV, MAP_DKV, r, scr, C.lane); continue; } r -= I_DKV;
            if (r < I_UKV) { cvt_item(ARG_IN(I_WUKV), 512, 4096, WUKV, MAP_ID, r, scr, C.lane); continue; } r -= I_UKV;
            if (r < I_DQ) { cvt_item(ARG_IN(I_WDQ), D, 512, WDQ, MAP_ID, r, scr, C.lane); continue; } r -= I_DQ;
            if (r < I_UQ) { cvt_item(ARG_IN(I_WUQ), 512, 3072, WUQ, MAP_UQ, r, scr, C.lane); continue; } r -= I_UQ;
            cvt_item(ARG_IN(I_WMO), D, D, WMO, MAP_ID, r, scr, C.lane);
        }
        { const int gt = C.vcu * 512 + C.tid, NGT = C.G * 512;
          for (int i = gt; i < 192 * 256; i += NGT) { const int rr = i >> 8, c16 = i & 255; const int row = rr < 96 ? 544 + rr : 672 + (rr - 96); *(GAS u32x4*)(WDKV + (size_t)row * D + c16 * 8) = (u32x4){0u, 0u, 0u, 0u}; }
          const int* pos = (const int*)ARG_IN(I_POS);
          for (int i = gt; i < M * 128; i += NGT) { const int m = i >> 7, j = i & 127; const float inv = (float)exp2(-(double)j * (13.287712379549449 / 128.0)); float cc, ss; sincos_acc((float)pos[m] * inv, cc, ss); COSR[i] = cc; SINR[i] = ss; }
          for (int i = gt; i < M * 32; i += NGT) { const int m = i >> 5, j = i & 31; const float inv = (float)exp2(-(double)j * (13.287712379549449 / 32.0)); float cc, ss; sincos_acc((float)pos[m] * inv, cc, ss); COSM[i] = cc; SINM[i] = ss; }
        }
}

__global__ void __launch_bounds__(512, 2) mk_fwd(Args args) {
    extern __shared__ __attribute__((aligned(16))) unsigned char lds_raw[];
    Ctx C;
    C.lds = (LAS unsigned char*)lds_raw;
    C.tid = threadIdx.x; C.lane = C.tid & 63; C.wave = __builtin_amdgcn_readfirstlane(C.tid >> 6);
    C.G = gridDim.x; { const int bx = blockIdx.x; C.vcu = (C.G % 8 == 0) ? (bx % 8) * (C.G / 8) + bx / 8 : bx; }
#define ws (argp()->ws)
    unsigned* ctl = (unsigned*)(ws + WS_CTL);
    volatile LAS unsigned* MISC = (volatile LAS unsigned*)(C.lds + MISC_OFF);
    for (int u = C.tid; u < (LDS_BYTES - LDSCTL_OFF) / 4; u += 512) ((LAS unsigned*)(C.lds + LDSCTL_OFF))[u] = 0u;
    __syncthreads();
    XcdBarrier bar; bar.bar = ctl + CW_BAR; bar.x = 0; bar.st = nullptr;
    if (!MK_PER_PHASE) bar = xcd_barrier_post(ctl + CW_BAR, MISC + 8);
    const int lo = argp()->ph_lo, hi = argp()->ph_hi;
#ifndef MK_ONLY
#define MK_ONLY -1
#endif
#define IN(k) ((MK_ONLY < 0 || MK_ONLY == (k)) && lo <= (k) && (k) < hi)
#ifndef MK_T0
#define MK_T0 -1
#define MK_T1 -1
#endif
    unsigned long long ev_t0 = 0ull;
#define CLK(t) asm volatile("s_memrealtime %0\n\ts_waitcnt lgkmcnt(0)" : "=s"(t) :: "memory")
#define EV(id) do { if ((id) == MK_T0) { CLK(ev_t0); } if ((id) == MK_T1) { unsigned long long t1_; CLK(t1_); if (C.tid == 0 && (int)blockIdx.x == MK_KPROBE_BLK) MISC[14] = (unsigned)(t1_ - ev_t0); } } while (0)
#define SEAM(k) do { EV(2 * (k) + 1); if (!MK_PER_PHASE && IN((k) + 1)) xcd_barrier(bar); EV(2 * (k) + 2); } while (0)
#define DBL(k, ...) do { __VA_ARGS__; if (MK_DOUBLE == (k)) { __VA_ARGS__; } } while (0)

#define x_in ARG_IN(I_X)
#define X (argp()->out)
#define MODSP ((float*)(ws + WS_MODSP))
#define MODS ((float*)(ws + WS_MODS))
#define COSR ((float*)(ws + WS_COSR))
#define SINR ((float*)(ws + WS_SINR))
#define COSM ((float*)(ws + WS_COSM))
#define SINM ((float*)(ws + WS_SINM))
#define RSTAT ((float*)(ws + WS_RSTAT))
#define SSQKV ((float*)(ws + WS_SSQKV))
#define SSQQ ((float*)(ws + WS_SSQQ))
#define WFI ((bf16*)(ws + WS_WFI))
#define WFO ((bf16*)(ws + WS_WFO))
#define WRI ((bf16*)(ws + WS_WRI))
#define WRO ((bf16*)(ws + WS_WRO))
#define WDKV ((bf16*)(ws + WS_WDKV))
#define WUKV ((bf16*)(ws + WS_WUKV))
#define WDQ ((bf16*)(ws + WS_WDQ))
#define WUQ ((bf16*)(ws + WS_WUQ))
#define WMO ((bf16*)(ws + WS_WMO))
#define H ((bf16*)(ws + WS_H))
#define HK ((bf16*)(ws + WS_HK))
#define A ((bf16*)(ws + WS_A))
#define RQ ((bf16*)(ws + WS_RQ))
#define RK ((bf16*)(ws + WS_RK))
#define RV ((bf16*)(ws + WS_RV))
#define RG ((bf16*)(ws + WS_RG))
#define RO ((bf16*)(ws + WS_RO))
#define CKVG ((bf16*)(ws + WS_CKVG))
#define CQG ((bf16*)(ws + WS_CQG))
#define KR ((bf16*)(ws + WS_KR))
#define KN ((bf16*)(ws + WS_KN))
#define VV ((bf16*)(ws + WS_VV))
#define QQ ((bf16*)(ws + WS_QQ))
#define AO ((bf16*)(ws + WS_AO))
#define norm_g ARG_IN(I_NORMG)

    EV(0);
    if (IN(0)) { DBL(0, prologue_phase(C, MODSP, WFI, WFO, WRI, WRO, WDKV, WUKV, WDQ, WUQ, WMO, COSR, SINR, COSM, SINM); SEAM(0)); }
    if (IN(1)) {
        const int gt = C.vcu * 512 + C.tid, NGT = C.G * 512;
        for (int i = gt; i < MODS_TOTAL; i += NGT) { float s = 0.f;
#pragma unroll
            for (int k = 0; k < 8; ++k) s += MODSP[(size_t)k * MODS_TOTAL + i];
            float bias; if (i < MODS_KV) { const int l = i / (4 * NMODV), n = i % NMODV; bias = ARG_IN(I_ADAB)[l * NMODV + n]; } else { bias = ARG_IN(I_KVAB)[(i - MODS_KV) % (2 * D)]; }
            MODS[i] = s + bias; }
        SEAM(1);
    }
#define MODL(l, k) (MODS + (size_t)(l) * 4 * NMODV + (size_t)(k) * D)
#define GEMMP(Aop, Bop, N_, K_, EpiT, ...) do { pg8::Gemm g_{(Aop), (Bop), M, (N_), (K_)}; pg8::PanelOrder S_; S_.init(M, (N_), C.G, (int)blockIdx.x); pg8::EpiT E_{__VA_ARGS__}; \
        pg8::gemm_phase<pg8::EpiT, pg8::PanelOrder>(C.lds, g_, S_, E_); } while (0)
#define GEMM(Aop, Bop, N_, K_, EpiT, ...) do { pg8::Gemm g_{(Aop), (Bop), M, (N_), (K_)}; pg8::StaticOrder S_; S_.init(M, (N_), C.G, (int)blockIdx.x); pg8::EpiT E_{__VA_ARGS__}; \
        pg8::gemm_phase<pg8::EpiT, pg8::StaticOrder>(C.lds, g_, S_, E_); } while (0)

    if (IN(2)) { norm_phase(C, x_in, norm_g + 0 * D, MODL(0, 0), MODL(0, 1), NMODV, H); SEAM(2); }
    if (IN(3)) { DBL(3, GEMM(H, WFI + 0 * WFI_ELEMS, 2 * FF, D, EpiSwiGLU, A); SEAM(3)); }
    if (IN(4)) { DBL(4, GEMMP(A, WFO + 0 * WFO_ELEMS, D, FF, EpiRes, x_in, X, MODL(0, 2), 0.5f); SEAM(4)); }
    if (IN(5)) { DBL(5, norm_phase(C, X, norm_g + 1 * D, MODL(0, 3), MODL(0, 4), NMODV, H); SEAM(5)); }
    if (IN(6)) { DBL(6, GEMM(H, WRI, RIN, D, EpiRet, RQ, RK, RV, RG, COSR, SINR); SEAM(6)); }
    if (IN(7)) { DBL(7, ret::retention_phase(C, RQ, RK, RV, RO, RSTAT); SEAM(7)); }
    if (IN(8)) { ret::gate_phase(C, RO, RG, RSTAT, ARG_IN(I_RGN)); SEAM(8); }
    if (IN(9)) { GEMMP(RG, WRO, D, 4096, EpiRes, X, X, MODL(0, 5), 1.0f); SEAM(9); }
    if (IN(10)) { norm_phase(C, X, norm_g + 2 * D, MODL(0, 6), MODL(0, 7), NMODV, H); SEAM(10); }
    if (IN(11)) { GEMM(H, WFI + 1 * WFI_ELEMS, 2 * FF, D, EpiSwiGLU, A); SEAM(11); }
    if (IN(12)) { GEMMP(A, WFO + 1 * WFO_ELEMS, D, FF, EpiRes, X, X, MODL(0, 8), 0.5f); SEAM(12); }
    if (IN(13)) { norm2_phase(C, X, ARG_IN(I_KVNG), MODS + MODS_KV, MODS + MODS_KV + D, 2 * D, HK, norm_g + 3 * D, MODL(1, 0), MODL(1, 1), NMODV, H); SEAM(13); }
    if (IN(14)) { GEMM(HK, WDKV, 768, D, EpiLatent, CKVG, ARG_IN(I_KVLG), SSQKV, KR, COSM, SINM); SEAM(14); }
    if (IN(15)) { GEMM(H, WFI + 2 * WFI_ELEMS, 2 * FF, D, EpiSwiGLU, A); SEAM(15); }
    if (IN(16)) { GEMMP(A, WFO + 2 * WFO_ELEMS, D, FF, EpiRes, X, X, MODL(1, 2), 0.5f); SEAM(16); }
    if (IN(17)) { norm_phase(C, X, norm_g + 4 * D, MODL(1, 3), MODL(1, 4), NMODV, H); SEAM(17); }
    if (IN(18)) { GEMM(H, WDQ, 512, D, EpiLatent, CQG, ARG_IN(I_QLG), SSQQ, nullptr, nullptr, nullptr); EV(60);
                  { pg8::Gemm g_{CKVG, WUKV, M, 4096, 512}; pg8::SkewOrder S_; S_.init(M, 4096, C.G, (int)blockIdx.x); pg8::EpiUkv E_{KN, VV, SSQKV};
                    pg8::gemm_phase<pg8::EpiUkv, pg8::SkewOrder>(C.lds, g_, S_, E_); } SEAM(18); }
    if (IN(19)) { GEMM(CQG, WUQ, 3072, 512, EpiUq, QQ, SSQQ, COSM, SINM, 0.07216878364870322f * 1.4426950408889634f); SEAM(19); }
    if (IN(20)) { DBL(20, att::attention_phase(C, QQ, KN, KR, VV, AO); SEAM(20)); }
    if (IN(21)) { GEMMP(AO, WMO, D, D, EpiRes, X, X, MODL(1, 5), 1.0f); SEAM(21); }
    if (IN(22)) { norm_phase(C, X, norm_g + 5 * D, MODL(1, 6), MODL(1, 7), NMODV, H); SEAM(22); }
    if (IN(23)) { GEMM(H, WFI + 3 * WFI_ELEMS, 2 * FF, D, EpiSwiGLU, A); SEAM(23); }
    if (IN(24)) { GEMMP(A, WFO + 3 * WFO_ELEMS, D, FF, EpiRes, X, X, MODL(1, 8), 0.5f); SEAM(24); }
    if (IN(25)) { final_norm_phase(C, X, ARG_IN(I_FING)); }
    EV(51);
    if ((MK_T1 >= 0 || MK_APROBE != 0) && (int)blockIdx.x == MK_KPROBE_BLK && C.tid == 0) { const unsigned d = MK_APROBE != 0 ? MISC[15] : 4u * MISC[14]; const unsigned long long t0 = (unsigned long long)wall_clock64(); while ((unsigned long long)wall_clock64() - t0 < (unsigned long long)d) __builtin_amdgcn_s_sleep(8); }
#undef IN
#undef SEAM
}

#undef A
#undef AO
#undef CKVG
#undef COSM
#undef COSR
#undef CQG
#undef H
#undef HK
#undef KN
#undef KR
#undef MODS
#undef MODSP
#undef QQ
#undef RG
#undef RK
#undef RO
#undef RQ
#undef RSTAT
#undef RV
#undef SINM
#undef SINR
#undef SSQKV
#undef SSQQ
#undef VV
#undef WDKV
#undef WDQ
#undef WFI
#undef WFO
#undef WMO
#undef WRI
#undef WRO
#undef WUKV
#undef WUQ
#undef ws
#undef X
#undef x_in
#undef norm_g
extern "C" void kernel_launch(void* const* d_in, const int* in_sizes, int n_in, void* d_out, int out_size, void* d_ws, size_t ws_size, hipStream_t stream) {
    static int grid = 0;
    if (grid == 0) {
        if (n_in != 22 || in_sizes[0] != M * D || out_size != M * D || ws_size < WS_END) { fprintf(stderr, "kernel_launch: unexpected problem shape (n_in %d, in0 %d, out %d, ws %zu; need ws >= %zu)\n", n_in, n_in > 0 ? in_sizes[0] : -1, out_size, ws_size, (size_t)WS_END); grid = -1; return; }
        int dev = 0, cus = 0, per_cu = 0;
        if (hipGetDevice(&dev) != hipSuccess || hipDeviceGetAttribute(&cus, hipDeviceAttributeMultiprocessorCount, dev) != hipSuccess) { grid = -1; return; }
        if (hipFuncSetAttribute((const void*)mk_fwd, hipFuncAttributeMaxDynamicSharedMemorySize, LDS_BYTES) != hipSuccess) { fprintf(stderr, "kernel_launch: hipFuncSetAttribute failed\n"); grid = -1; return; }
        if (hipOccupancyMaxActiveBlocksPerMultiprocessor(&per_cu, (const void*)mk_fwd, 512, LDS_BYTES) != hipSuccess || per_cu < 1)
            fprintf(stderr, "kernel_launch: note: occupancy query reports %d workgroups per CU\n", per_cu);
        (void)hipGetLastError();
        grid = cus;
    }
    if (grid < 0) return;
    if (hipMemsetAsync((char*)d_ws + WS_CTL, 0, CTL_ZERO_BYTES, stream) != hipSuccess) return;
    Args a{};
    for (int i = 0; i < 22; ++i) a.in[i] = (const float*)d_in[i];
    a.out = (float*)d_out; a.ws = (unsigned char*)d_ws;
#if MK_PER_PHASE
    for (int p = 0; p < N_PHASES; ++p) { a.ph_lo = p; a.ph_hi = p + 1; hipLaunchKernelGGL(mk_fwd, dim3(grid), dim3(512), LDS_BYTES, stream, a); }
#else
    a.ph_lo = 0; a.ph_hi = N_PHASES;
    hipLaunchKernelGGL(mk_fwd, dim3(grid), dim3(512), LDS_BYTES, stream, a);
#endif
    const hipError_t le = hipPeekAtLastError();
    if (le != hipSuccess) fprintf(stderr, "kernel_launch: launch failed: %s\n", hipGetErrorName(le));
}
```
